# Optimizing an MI355X kernel written in HIP

```python
import jax
import jax.numpy as jnp
from jax import lax
import numpy as np

D_MODEL = 1024
BATCH = 32
SEQ = 2048
DEPTH = 2

GRID_W = 64
CTX_LEN = 256
N_HEADS_ATTN = 8
N_KV = 2
HEAD_DIM = 64
AXIS_DIM = HEAD_DIM // 2
ATTN_W = N_HEADS_ATTN * HEAD_DIM
KV_W = N_KV * HEAD_DIM
WINDOW = 128
QBLOCK = 128
ROPE_BASE = 10000.0
LRU_W = 512
LRU_BLOCKS = 8
LRU_BS = LRU_W // LRU_BLOCKS
CONV_W = 4
CONV_LEFT = 2
LRU_C = 8.0
MIX_IN = ATTN_W + 2 * KV_W + 2 * LRU_W
MIX_OUT = ATTN_W + LRU_W
RWKV_H = 16
RWKV_HD = D_MODEL // RWKV_H
DECAY_LORA = 64
ICLR_LORA = 64
GATE_LORA = 160
GN_EPS = 64e-5
N_EXPERTS = 16
EXPERT_FF = 1024
CAPACITY = 2
NORM_EPS = 1e-6
NEG_INF = -1e30
N_A_LAYERS = (DEPTH + 1) // 2
N_C_LAYERS = DEPTH // 2

kernel_name = 'hybrid_dit_swa_rglru_rwkv7_ecmoe'


def rmsnorm(x, g):
    xf = x.astype(jnp.float32)
    y = xf * lax.rsqrt(jnp.mean(xf * xf, axis=-1, keepdims=True) + NORM_EPS)
    return (y * g.astype(jnp.float32)).astype(x.dtype)


def modulate(h, shift, scale):
    return h * (1 + scale) + shift


def axial_angles(rows):
    row = jnp.repeat(jnp.arange(rows), GRID_W).astype(jnp.float32)
    col = jnp.tile(jnp.arange(GRID_W), rows).astype(jnp.float32)
    inv = ROPE_BASE ** (-jnp.arange(0, AXIS_DIM, 2, dtype=jnp.float32) / AXIS_DIM)
    return row[:, None] * inv, col[:, None] * inv


def rope_axis(x, ang):
    c = jnp.cos(ang)[:, None, :]
    s = jnp.sin(ang)[:, None, :]
    x1, x2 = jnp.split(x.astype(jnp.float32), 2, axis=-1)
    return jnp.concatenate([x1 * c - x2 * s, x2 * c + x1 * s], axis=-1)


def axial_rope(x, ang_row, ang_col):
    return jnp.concatenate([rope_axis(x[..., :AXIS_DIM], ang_row),
                            rope_axis(x[..., AXIS_DIM:], ang_col)], axis=-1).astype(x.dtype)


def local_attention(q, k, v, kc, vc, sink):
    B, S, H, hd = q.shape
    G = H // N_KV
    Lc = kc.shape[1]
    span = QBLOCK + 2 * WINDOW
    qg = (q * hd ** -0.5).reshape(B, S, N_KV, G, hd)
    pad = ((0, 0), (WINDOW, WINDOW), (0, 0), (0, 0))
    kp = jnp.pad(k, pad)
    vp = jnp.pad(v, pad)
    rel = jnp.arange(span)[None, :] - WINDOW - jnp.arange(QBLOCK)[:, None]
    band = jnp.abs(rel) <= WINDOW
    sink_b = jnp.broadcast_to(sink.reshape(N_KV, G, 1, 1).astype(jnp.float32), (B, N_KV, G, QBLOCK, 1))

    def block(i):
        start = i * QBLOCK
        qb = lax.dynamic_slice_in_dim(qg, start, QBLOCK, axis=1)
        kb = lax.dynamic_slice_in_dim(kp, start, span, axis=1)
        vb = lax.dynamic_slice_in_dim(vp, start, span, axis=1)
        kpos = start - WINDOW + jnp.arange(span)
        valid = band & ((kpos >= 0) & (kpos < S))[None, :]
        s_ctx = jnp.einsum('bqkgd,bckd->bkgqc', qb, kc).astype(jnp.float32)
        s_win = jnp.where(valid, jnp.einsum('bqkgd,bjkd->bkgqj', qb, kb).astype(jnp.float32), NEG_INF)
        p = jax.nn.softmax(jnp.concatenate([s_ctx, s_win, sink_b], axis=-1), axis=-1).astype(v.dtype)
        return (jnp.einsum('bkgqc,bckd->bqkgd', p[..., :Lc], vc)
                + jnp.einsum('bkgqj,bjkd->bqkgd', p[..., Lc:Lc + span], vb))

    out = lax.map(block, jnp.arange(S // QBLOCK))
    return jnp.moveaxis(out, 0, 1).reshape(B, S, H * hd)


def context_attention(qc, kc, vc, sink):
    B, Lc, H, hd = qc.shape
    G = H // N_KV
    qg = (qc * hd ** -0.5).reshape(B, Lc, N_KV, G, hd)
    s = jnp.einsum('bqkgd,bckd->bkgqc', qg, kc).astype(jnp.float32)
    sink_b = jnp.broadcast_to(sink.reshape(N_KV, G, 1, 1).astype(jnp.float32), (B, N_KV, G, Lc, 1))
    p = jax.nn.softmax(jnp.concatenate([s, sink_b], axis=-1), axis=-1)[..., :Lc].astype(vc.dtype)
    return jnp.einsum('bkgqc,bckd->bqkgd', p, vc).reshape(B, Lc, H * hd)


def centred_dwconv(u, w, b):
    n = u.shape[1]
    up = jnp.pad(u, ((0, 0), (CONV_LEFT, CONV_W - 1 - CONV_LEFT), (0, 0)))
    out = up[:, 0:n] * w[0]
    for j in range(1, CONV_W):
        out = out + up[:, j:j + n] * w[j]
    return out + b


def block_diag_linear(u, w, b):
    B, N, _ = u.shape
    y = jnp.einsum('bnhi,hij->bnhj', u.reshape(B, N, LRU_BLOCKS, LRU_BS), w)
    return y.reshape(B, N, LRU_W) + b


def rglru_coeffs(u, wa, ba, wi, bi, lam):
    r = jax.nn.sigmoid(block_diag_linear(u, wa, ba))
    i = jax.nn.sigmoid(block_diag_linear(u, wi, bi))
    log_a = (-LRU_C * r * jax.nn.softplus(-lam)).astype(jnp.float32)
    a = jnp.exp(log_a)
    mult = jnp.sqrt(jnp.maximum(-jnp.expm1(2 * log_a), 0.0))
    return a, mult * (i * u).astype(jnp.float32)


def linear_scan(a, b, h0):
    def combine(e1, e2):
        a1, b1 = e1
        a2, b2 = e2
        return a1 * a2, a2 * b1 + b2
    A, Bc = lax.associative_scan(combine, (a, b), axis=1)
    return A * h0[:, None, :] + Bc


def rglru_bidir(ul, uc, wa, ba, wi, bi, lam, need_ctx_out):
    B = ul.shape[0]
    outs_l, outs_c = [], []
    for d in range(2):
        al, bl = rglru_coeffs(ul, wa[d], ba[d], wi[d], bi[d], lam[d])
        ac, bc = rglru_coeffs(uc, wa[d], ba[d], wi[d], bi[d], lam[d])
        if d == 1:
            al, bl, ac, bc = (jnp.flip(t, 1) for t in (al, bl, ac, bc))
        hc = linear_scan(ac, bc, jnp.zeros((B, LRU_W), jnp.float32))
        hl = linear_scan(al, bl, hc[:, -1])
        outs_l.append(jnp.flip(hl, 1) if d == 1 else hl)
        if need_ctx_out:
            outs_c.append(jnp.flip(hc, 1) if d == 1 else hc)
    yl = (outs_l[0] + outs_l[1]).astype(ul.dtype)
    yc = (outs_c[0] + outs_c[1]).astype(uc.dtype) if need_ctx_out else None
    return yl, yc


def attn_lru_mixer(hl, hc, ang_row, ang_col, w_in, w_out, sink, conv_w, conv_b,
                   wa, ba, wi, bi, lam, need_ctx_out):
    B, S, _ = hl.shape
    Lc = hc.shape[1]
    cuts = [ATTN_W, ATTN_W + KV_W, ATTN_W + 2 * KV_W, ATTN_W + 2 * KV_W + LRU_W]
    q, k, v, ul, gl = jnp.split(hl @ w_in, cuts, axis=-1)
    q = axial_rope(q.reshape(B, S, N_HEADS_ATTN, HEAD_DIM), ang_row, ang_col)
    k = axial_rope(k.reshape(B, S, N_KV, HEAD_DIM), ang_row, ang_col)
    v = v.reshape(B, S, N_KV, HEAD_DIM)
    if need_ctx_out:
        qc, kc, vc, uc, gc = jnp.split(hc @ w_in, cuts, axis=-1)
    else:
        kc, vc, uc = jnp.split(hc @ w_in[:, ATTN_W:cuts[3]], [KV_W, 2 * KV_W], axis=-1)
    kc = kc.reshape(B, Lc, N_KV, HEAD_DIM)
    vc = vc.reshape(B, Lc, N_KV, HEAD_DIM)
    attn_l = local_attention(q, k, v, kc, vc, sink)
    rl, rc = rglru_bidir(centred_dwconv(ul, conv_w, conv_b), centred_dwconv(uc, conv_w, conv_b),
                         wa, ba, wi, bi, lam, need_ctx_out)
    yl = jnp.concatenate([attn_l, rl * jax.nn.gelu(gl)], axis=-1) @ w_out
    if not need_ctx_out:
        return yl, None
    attn_c = context_attention(qc.reshape(B, Lc, N_HEADS_ATTN, HEAD_DIM), kc, vc, sink)
    yc = jnp.concatenate([attn_c, rc * jax.nn.gelu(gc)], axis=-1) @ w_out
    return yl, yc


def centred_shift(h):
    hp = jnp.pad(h, ((0, 0), (1, 1), (0, 0)))
    return 0.5 * (hp[:, :-2] + hp[:, 2:])


def l2_normalize(t):
    tf = t.astype(jnp.float32)
    return (tf * lax.rsqrt(jnp.maximum(jnp.sum(tf * tf, axis=-1, keepdims=True), 1e-24))).astype(t.dtype)


def head_groupnorm(y, g, b):
    B, N, H, hd = y.shape
    yf = y.astype(jnp.float32)
    mu = jnp.mean(yf, axis=-1, keepdims=True)
    var = jnp.mean(jnp.square(yf - mu), axis=-1, keepdims=True)
    yn = ((yf - mu) * lax.rsqrt(var + GN_EPS)).reshape(B, N, H * hd)
    return yn * g.astype(jnp.float32) + b.astype(jnp.float32)


def rwkv7_inputs(h, mu, w_rkv, w0, w1, w2, a0, a1, a2, g1, g2, k_k, k_a, with_out):
    B, N, _ = h.shape

    def heads(t):
        return t.reshape(B, N, RWKV_H, RWKV_HD)

    xx = centred_shift(h) - h
    xw = h + xx * mu[1]
    xa = h + xx * mu[4]
    k = (h + xx * mu[2]) @ w_rkv[1]
    v = heads((h + xx * mu[3]) @ w_rkv[2])
    kk = l2_normalize(heads(k * k_k))
    dirs = []
    for d in range(2):
        w_log = -jax.nn.softplus(-(w0[d] + jnp.tanh(xw @ w1[d]) @ w2[d]).astype(jnp.float32)) - 0.5
        decay = jnp.exp(-jnp.exp(w_log))
        a = jax.nn.sigmoid(a0[d] + (xa @ a1[d]) @ a2[d])
        kd = k * (1 + (a - 1) * k_a)
        dirs.append((heads(decay), heads(kd), heads(a)))
    if with_out:
        r = heads((h + xx * mu[0]) @ w_rkv[0])
        g = jax.nn.sigmoid((h + xx * mu[5]) @ g1) @ g2
    else:
        r = None
        g = None
    return r, g, v, kk, dirs


def wkv_scan(s0, decay, k, v, kk, a, r, reverse):
    def seq(t):
        return jnp.moveaxis(t.astype(jnp.float32), 1, 0)
    xs = (seq(decay), seq(k), seq(v), seq(-kk), seq(kk * a))
    if r is not None:
        xs = xs + (seq(r),)

    def step(s, inp):
        w_t, k_t, v_t, a_t, b_t = inp[:5]
        sa = jnp.einsum('bhvk,bhk->bhv', s, a_t)
        s = s * w_t[:, :, None, :] + sa[..., None] * b_t[:, :, None, :] + v_t[..., None] * k_t[:, :, None, :]
        y = jnp.einsum('bhvk,bhk->bhv', s, inp[5]) if r is not None else None
        return s, y

    s_fin, ys = lax.scan(step, s0, xs, reverse=reverse)
    return s_fin, (jnp.moveaxis(ys, 0, 1) if r is not None else None)


def rwkv7_mixer(hl, hc, mu, w_rkv, w0, w1, w2, a0, a1, a2, g1, g2, k_k, k_a, r_k,
                gn_g, gn_b, w_o, need_ctx_out):
    B = hl.shape[0]
    rl, gl, vl, kkl, dirs_l = rwkv7_inputs(hl, mu, w_rkv, w0, w1, w2, a0, a1, a2, g1, g2, k_k, k_a, True)
    rc, gc, vc, kkc, dirs_c = rwkv7_inputs(hc, mu, w_rkv, w0, w1, w2, a0, a1, a2, g1, g2, k_k, k_a, need_ctx_out)
    ys_l, bon_l, ys_c, bon_c = [], [], [], []
    for d in range(2):
        reverse = d == 1
        dec_c, k_c, a_c = dirs_c[d]
        s0 = jnp.zeros((B, RWKV_H, RWKV_HD, RWKV_HD), jnp.float32)
        s_ctx, y_c = wkv_scan(s0, dec_c, k_c, vc, kkc, a_c, rc, reverse)
        dec_l, k_l, a_l = dirs_l[d]
        _, y_l = wkv_scan(s_ctx, dec_l, k_l, vl, kkl, a_l, rl, reverse)
        ys_l.append(y_l)
        bon_l.append(jnp.sum(rl * k_l * r_k, axis=-1, keepdims=True) * vl)
        if need_ctx_out:
            ys_c.append(y_c)
            bon_c.append(jnp.sum(rc * k_c * r_k, axis=-1, keepdims=True) * vc)

    def finish(ys, bons, g):
        Bg, N, _ = g.shape
        o = head_groupnorm(ys[0] + ys[1], gn_g, gn_b).astype(g.dtype) + (bons[0] + bons[1]).reshape(Bg, N, D_MODEL)
        return (o * g) @ w_o

    yl = finish(ys_l, bon_l, gl)
    yc = finish(ys_c, bon_c, gc) if need_ctx_out else None
    return yl, yc


def expert_choice_moe(h, w_router, w1, w3, w2):
    B, N, _ = h.shape
    cap = CAPACITY * N // N_EXPERTS
    aff = jax.nn.softmax(jnp.einsum('bnd,de->ben', h, w_router).astype(jnp.float32), axis=1)
    gate, idx = lax.top_k(aff, cap)
    bidx = jnp.arange(B)[:, None, None]
    xin = h[bidx, idx]
    hid = jax.nn.silu(jnp.einsum('becd,edf->becf', xin, w1)) * jnp.einsum('becd,edf->becf', xin, w3)
    y = jnp.einsum('becf,efd->becd', hid, w2) * gate[..., None].astype(h.dtype)
    return jnp.zeros_like(h).at[bidx, idx].add(y)


def setup_inputs(seed: int = 0) -> dict:
    key = jax.random.key(seed)
    keys = iter(jax.random.split(key, 64))

    def nrm(shape, scale):
        return jax.random.normal(next(keys), shape, jnp.float32) * scale

    def uni(shape, lo, hi):
        return jax.random.uniform(next(keys), shape, jnp.float32, lo, hi)

    D = D_MODEL
    NA = N_A_LAYERS
    NC = N_C_LAYERS
    lru_a = uni((NA, 2, LRU_W), 0.9, 0.999) ** (1.0 / LRU_C)
    return {
        'x': nrm((BATCH, SEQ, D), 1.0),
        'c': nrm((BATCH, D), 1.0),
        'ctx': nrm((BATCH, CTX_LEN, D), 1.0),
        'c_ctx': nrm((D,), 1.0),
        'mod_w': nrm((DEPTH, D, 6 * D), 0.5 * D ** -0.5),
        'mod_b': nrm((DEPTH, 6 * D), 0.01),
        'norm_mix': 1.0 + nrm((DEPTH, D), 0.05),
        'norm_ffn': 1.0 + nrm((DEPTH, D), 0.05),
        'router_w': nrm((DEPTH, D, N_EXPERTS), D ** -0.5),
        'exp_w1': nrm((DEPTH, N_EXPERTS, D, EXPERT_FF), D ** -0.5),
        'exp_w3': nrm((DEPTH, N_EXPERTS, D, EXPERT_FF), D ** -0.5),
        'exp_w2': nrm((DEPTH, N_EXPERTS, EXPERT_FF, D), EXPERT_FF ** -0.5),
        'mix_in': nrm((NA, D, MIX_IN), D ** -0.5),
        'mix_out': nrm((NA, MIX_OUT, D), MIX_OUT ** -0.5),
        'attn_sink': nrm((NA, N_HEADS_ATTN), 1.0),
        'lru_conv_w': nrm((NA, CONV_W, LRU_W), CONV_W ** -0.5),
        'lru_conv_b': nrm((NA, LRU_W), 0.01),
        'lru_wa': nrm((NA, 2, LRU_BLOCKS, LRU_BS, LRU_BS), LRU_BS ** -0.5),
        'lru_ba': nrm((NA, 2, LRU_W), 0.01),
        'lru_wi': nrm((NA, 2, LRU_BLOCKS, LRU_BS, LRU_BS), LRU_BS ** -0.5),
        'lru_bi': nrm((NA, 2, LRU_W), 0.01),
        'lru_lam': jnp.log(lru_a) - jnp.log1p(-lru_a),
        'rw_mu': uni((NC, 6, D), 0.0, 1.0),
        'rw_rkv': nrm((NC, 3, D, D), D ** -0.5),
        'rw_w0': uni((NC, 2, D), -6.0, -1.0),
        'rw_w1': nrm((NC, 2, D, DECAY_LORA), D ** -0.5),
        'rw_w2': nrm((NC, 2, DECAY_LORA, D), 0.1 * DECAY_LORA ** -0.5),
        'rw_a0': nrm((NC, 2, D), 0.1),
        'rw_a1': nrm((NC, 2, D, ICLR_LORA), D ** -0.5),
        'rw_a2': nrm((NC, 2, ICLR_LORA, D), 0.1 * ICLR_LORA ** -0.5),
        'rw_g1': nrm((NC, D, GATE_LORA), D ** -0.5),
        'rw_g2': nrm((NC, GATE_LORA, D), GATE_LORA ** -0.5),
        'rw_kk': 1.0 + nrm((NC, D), 0.1),
        'rw_ka': 1.0 + nrm((NC, D), 0.1),
        'rw_rk': nrm((NC, RWKV_H, RWKV_HD), 0.1),
        'rw_gn_g': 1.0 + nrm((NC, D), 0.05),
        'rw_gn_b': nrm((NC, D), 0.01),
        'rw_wo': nrm((NC, D, D), D ** -0.5),
        'final_norm': 1.0 + nrm((D,), 0.05),
    }


def reference(x, c, ctx, c_ctx, mod_w, mod_b, norm_mix, norm_ffn, router_w, exp_w1, exp_w3, exp_w2,
              mix_in, mix_out, attn_sink, lru_conv_w, lru_conv_b, lru_wa, lru_ba, lru_wi, lru_bi, lru_lam,
              rw_mu, rw_rkv, rw_w0, rw_w1, rw_w2, rw_a0, rw_a1, rw_a2, rw_g1, rw_g2, rw_kk, rw_ka, rw_rk,
              rw_gn_g, rw_gn_b, rw_wo, final_norm):
    ROWS = x.shape[1] // GRID_W
    ang_row, ang_col = axial_angles(ROWS)
    s_lat = jax.nn.silu(c)
    s_ctx = jax.nn.silu(c_ctx)
    xl, xc = x, ctx
    for layer in range(DEPTH):
        last = layer == DEPTH - 1
        i = layer // 2
        m_l = jnp.split((s_lat @ mod_w[layer] + mod_b[layer])[:, None, :], 6, axis=-1)
        m_c = jnp.split(s_ctx @ mod_w[layer] + mod_b[layer], 6, axis=-1)
        hl = modulate(rmsnorm(xl, norm_mix[layer]), m_l[0], m_l[1])
        hc = modulate(rmsnorm(xc, norm_mix[layer]), m_c[0], m_c[1])
        if layer % 2 == 0:
            yl, yc = attn_lru_mixer(hl, hc, ang_row, ang_col, mix_in[i], mix_out[i], attn_sink[i],
                                    lru_conv_w[i], lru_conv_b[i], lru_wa[i], lru_ba[i], lru_wi[i],
                                    lru_bi[i], lru_lam[i], not last)
        else:
            yl, yc = rwkv7_mixer(hl, hc, rw_mu[i], rw_rkv[i], rw_w0[i], rw_w1[i], rw_w2[i], rw_a0[i],
                                 rw_a1[i], rw_a2[i], rw_g1[i], rw_g2[i], rw_kk[i], rw_ka[i], rw_rk[i],
                                 rw_gn_g[i], rw_gn_b[i], rw_wo[i], not last)
        xl = xl + m_l[2] * yl
        hl = modulate(rmsnorm(xl, norm_ffn[layer]), m_l[3], m_l[4])
        xl = xl + m_l[5] * expert_choice_moe(hl, router_w[layer], exp_w1[layer], exp_w3[layer], exp_w2[layer])
        if not last:
            xc = xc + m_c[2] * yc
            hc = modulate(rmsnorm(xc, norm_ffn[layer]), m_c[3], m_c[4])
            xc = xc + m_c[5] * expert_choice_moe(hc, router_w[layer], exp_w1[layer], exp_w3[layer], exp_w2[layer])
    return rmsnorm(xl, final_norm)
```

```cpp
#include <hip/hip_runtime.h>
#include <cstdio>
#include <cstdint>
namespace pg8 {
#define PG8_LAS __attribute__((address_space(3)))
typedef unsigned short bf16_t;
typedef short bf16x8 __attribute__((ext_vector_type(8)));
typedef float f32x4 __attribute__((ext_vector_type(4)));
typedef unsigned u32x4 __attribute__((ext_vector_type(4)));
constexpr int BM = 256, BK = 64, HALF = 128, HTB = HALF * BK * 2  , STAGE_BYTES = 8 * HTB, NXCD = 8, WGM = 8;

__host__ __device__ __forceinline__ int lds_byte(int r, int c) { const int st = (r >> 4) * 2 + (c >> 5), rr = r & 15, cc = c & 31, ob = rr * 64 + cc * 2; return st * 1024 + (ob ^ (((ob >> 9) & 1) << 5)); }
__host__ __device__ __forceinline__ void stage_rc(int b, int& R, int& C) { const int st = b / 1024, sb = b % 1024, swz = sb ^ (((sb >> 9) & 1) << 5); R = (st >> 1) * 16 + swz / 64; C = (st & 1) * 32 + (swz % 64) / 2; }
__host__ __device__ __forceinline__ int perm32(int rho) { const int n = rho >> 4, i = rho & 15; return 8 * (i >> 2) + 4 * n + (i & 3); }

struct Unit { int pm, pn; };
struct Gemm { const bf16_t* A; const bf16_t* Bt; int M, N, K; int lda; int tpg; size_t bgs; const int* gidx; };

struct StaticOrder {
    int nM, nN, nwg, G, c, skip;
    __host__ __device__ void init(int M, int N, int G_, int c_) { nM = M / BM; nN = N / BM; nwg = nM * nN; G = G_; c = c_; skip = 0; }
    __host__ __device__ bool next(int i, Unit& u) const {
        long L;
        if (skip == 0) L = (long)i * G + c;
        else { const int cp = (c - skip + G) % G; L = (c >= skip) ? (i == 0 ? (long)(c - skip) : (long)(G - skip) + (long)(i - 1) * G + cp) : (long)(G - skip) + (long)i * G + cp; }
        if (L >= nwg) return false;
        int wgid = (int)L; { const int q = nwg / NXCD, r = nwg % NXCD, xcd = wgid % NXCD, off = wgid / NXCD; wgid = (xcd < r ? xcd * (q + 1) : r * (q + 1) + (xcd - r) * q) + off; }
        const int nig = WGM * nN, gid = wgid / nig, fm = gid * WGM, gsz = (nM - fm) < WGM ? (nM - fm) : WGM;
        u.pm = fm + ((wgid % nig) % gsz); u.pn = (wgid % nig) / gsz; return true;
    }
    __device__ __forceinline__ void a_ready(const Unit&) const {}
    __device__ __forceinline__ void done(const Unit&) const {}
};

__device__ __forceinline__ unsigned cvt_pk_bf16(float lo, float hi) { unsigned r; asm volatile("v_cvt_pk_bf16_f32 %0, %1, %2" : "=v"(r) : "v"(lo), "v"(hi)); return r; }
typedef float f32x2 __attribute__((ext_vector_type(2)));
typedef float f32x2 __attribute__((ext_vector_type(2)));
typedef unsigned u32x2 __attribute__((ext_vector_type(2)));
struct EpiBf16 {
    static constexpr bool PERM = true, AFTER_DRAIN = false;
    bf16_t* O; int ldc;
    __device__ __forceinline__ void operator()(const f32x4 (&acc)[2][2][4][2], const Unit& u, int wr, int wc, int fr, int fq) const {
        const int row0 = u.pm * BM + wr * 64 + fr; const int col0 = u.pn * BM + wc * 32 + 8 * fq;
#pragma unroll
        for (int ai = 0; ai < 2; ++ai)
#pragma unroll
            for (int m = 0; m < 4; ++m) { bf16_t* rowp = O + (size_t)(row0 + ai * HALF + m * 16) * ldc + col0;
#pragma unroll
                for (int bj = 0; bj < 2; ++bj) { const f32x4 v0 = acc[ai][bj][m][0], v1 = acc[ai][bj][m][1];
                    u32x4 w; w.x = cvt_pk_bf16(v0[0], v0[1]); w.y = cvt_pk_bf16(v0[2], v0[3]); w.z = cvt_pk_bf16(v1[0], v1[1]); w.w = cvt_pk_bf16(v1[2], v1[3]);
                    *(u32x4*)(rowp + bj * HALF) = w; } }
    }
};
struct EpiRowScale {
    static constexpr bool PERM = true, AFTER_DRAIN = false;
    bf16_t* O; int ldc; const float* gate;
    __device__ __forceinline__ void operator()(const f32x4 (&acc)[2][2][4][2], const Unit& u, int wr, int wc, int fr, int fq) const {
        const int row0 = u.pm * BM + wr * 64 + fr; const int col0 = u.pn * BM + wc * 32 + 8 * fq;
#pragma unroll
        for (int ai = 0; ai < 2; ++ai)
#pragma unroll
            for (int m = 0; m < 4; ++m) { const int row = row0 + ai * HALF + m * 16; const float gs = gate[row]; bf16_t* rowp = O + (size_t)row * ldc + col0;
#pragma unroll
                for (int bj = 0; bj < 2; ++bj) { const f32x4 v0 = acc[ai][bj][m][0] * gs, v1 = acc[ai][bj][m][1] * gs;
                    u32x4 w; w.x = cvt_pk_bf16(v0[0], v0[1]); w.y = cvt_pk_bf16(v0[2], v0[3]); w.z = cvt_pk_bf16(v1[0], v1[1]); w.w = cvt_pk_bf16(v1[2], v1[3]);
                    *(u32x4*)(rowp + bj * HALF) = w; } }
    }
};
struct EpiSwiglu {
    static constexpr bool PERM = true, AFTER_DRAIN = false;
    bf16_t* O; int ldc;
    __device__ __forceinline__ void operator()(const f32x4 (&acc)[2][2][4][2], const Unit& u, int wr, int wc, int fr, int fq) const {
        const int row0 = u.pm * BM + wr * 64 + fr; const int col0 = u.pn * (BM / 2) + wc * 32 + 8 * fq;
#pragma unroll
        for (int ai = 0; ai < 2; ++ai)
#pragma unroll
            for (int m = 0; m < 4; ++m) { bf16_t* rowp = O + (size_t)(row0 + ai * HALF + m * 16) * ldc + col0; float h[8];
#pragma unroll
                for (int bj = 0; bj < 2; ++bj) { const f32x4 a = acc[ai][bj][m][0], b = acc[ai][bj][m][1];
#pragma unroll
                    for (int i = 0; i < 4; ++i) h[4 * bj + i] = a[i] / (1.f + __expf(-a[i])) * b[i]; }
                u32x4 w; w.x = cvt_pk_bf16(h[0], h[1]); w.y = cvt_pk_bf16(h[2], h[3]); w.z = cvt_pk_bf16(h[4], h[5]); w.w = cvt_pk_bf16(h[6], h[7]);
                *(u32x4*)rowp = w; }
    }
};
struct EpiRes {
    static constexpr bool PERM = true, AFTER_DRAIN = false;
    const void* base_l; bf16_t* out_l; const void* base_c; bf16_t* out_c; const float* gate; int nlat, rows_per_b, gstride, pl, pc, b16;
    __device__ __forceinline__ void operator()(const f32x4 (&acc)[2][2][4][2], const Unit& u, int wr, int wc, int fr, int fq) const {
        const int trow = u.pm * BM; const bool isc = trow >= nlat;
        const void* base = isc ? base_c : base_l; bf16_t* out = isc ? out_c : out_l; const int pitch = isc ? pc : pl;
        const int rbase = (isc ? trow - nlat : trow) + wr * 64 + fr; const int gb = isc ? 32 : trow / rows_per_b;
        const int col0 = u.pn * BM + wc * 32 + 8 * fq; const float* gp = gate + (size_t)gb * gstride + col0;
        f32x4 gv[4];
#pragma unroll
        for (int q = 0; q < 4; ++q) gv[q] = *(const f32x4*)(gp + (q >> 1) * HALF + (q & 1) * 4);
        f32x4 cur[4], nxt[4];
#define RES_LOAD(dst_, gi_) do { const size_t r_ = (size_t)(rbase + ((gi_) >> 2) * HALF + ((gi_) & 3) * 16); _Pragma("unroll") for (int bj_ = 0; bj_ < 2; ++bj_) { const int c_ = col0 + bj_ * HALF; \
            if (b16) { const u32x4 p_ = *(const u32x4*)((const bf16_t*)base + r_ * pitch + c_); dst_[2 * bj_] = (f32x4){__uint_as_float(p_.x << 16), __uint_as_float(p_.x & 0xffff0000u), __uint_as_float(p_.y << 16), __uint_as_float(p_.y & 0xffff0000u)}; \
                dst_[2 * bj_ + 1] = (f32x4){__uint_as_float(p_.z << 16), __uint_as_float(p_.z & 0xffff0000u), __uint_as_float(p_.w << 16), __uint_as_float(p_.w & 0xffff0000u)}; } \
            else { dst_[2 * bj_] = *(const f32x4*)((const float*)base + r_ * 1024 + c_); dst_[2 * bj_ + 1] = *(const f32x4*)((const float*)base + r_ * 1024 + c_ + 4); } } } while (0)
        RES_LOAD(cur, 0);
#pragma unroll
        for (int gi = 0; gi < 8; ++gi) { const int ai = gi >> 2, m = gi & 3;
            if (gi + 1 < 8) RES_LOAD(nxt, gi + 1);
            const size_t r = (size_t)(rbase + ai * HALF + m * 16);
#pragma unroll
            for (int bj = 0; bj < 2; ++bj) { const f32x4 o0 = cur[2 * bj] + gv[2 * bj] * acc[ai][bj][m][0], o1 = cur[2 * bj + 1] + gv[2 * bj + 1] * acc[ai][bj][m][1];
                u32x4 w; w.x = cvt_pk_bf16(o0[0], o0[1]); w.y = cvt_pk_bf16(o0[2], o0[3]); w.z = cvt_pk_bf16(o1[0], o1[1]); w.w = cvt_pk_bf16(o1[2], o1[3]); *(u32x4*)(out + r * pitch + col0 + bj * HALF) = w; }
#pragma unroll
            for (int q = 0; q < 4; ++q) cur[q] = nxt[q];
            asm volatile("" ::: "memory"); }
#undef RES_LOAD
    }
};
struct EpiRwkv {
    static constexpr bool PERM = true, AFTER_DRAIN = false;
    bf16_t* Kb; bf16_t* V; bf16_t* L; int nlat; int pn_off;
    __device__ __forceinline__ void operator()(const f32x4 (&acc)[2][2][4][2], const Unit& u0, int wr, int wc, int fr, int fq) const {
        Unit u; u.pm = u0.pm; u.pn = u0.pn + pn_off;
        const int row0 = u.pm * BM + wr * 64 + fr; const int lc0 = wc * 32 + 8 * fq;
        if (u.pn < 8) {
            const int t = u.pn >> 2;
            bf16_t* const pk = Kb; bf16_t* const pv = V;
            bf16_t* base = (t == 0) ? pk : pv; base += (u.pn & 3) * BM + lc0;
            {
#pragma unroll
            for (int ai = 0; ai < 2; ++ai)
#pragma unroll
                for (int m = 0; m < 4; ++m) { bf16_t* rowp = base + (size_t)(row0 + ai * HALF + m * 16) * 1024;
#pragma unroll
                    for (int bj = 0; bj < 2; ++bj) { const f32x4 v0 = acc[ai][bj][m][0], v1 = acc[ai][bj][m][1];
                        u32x4 w; w.x = cvt_pk_bf16(v0[0], v0[1]); w.y = cvt_pk_bf16(v0[2], v0[3]); w.z = cvt_pk_bf16(v1[0], v1[1]); w.w = cvt_pk_bf16(v1[2], v1[3]);
                        *(u32x4*)(rowp + bj * HALF) = w; } } }
        } else {
            const bool sig = (u.pn == 9);
#pragma unroll
            for (int ai = 0; ai < 2; ++ai)
#pragma unroll
                for (int m = 0; m < 4; ++m) { bf16_t* rowp = L + (size_t)(row0 + ai * HALF + m * 16) * 512 + (sig ? 256 : 0) + lc0;
#pragma unroll
                    for (int bj = 0; bj < 2; ++bj) { const f32x4 v0 = acc[ai][bj][m][0], v1 = acc[ai][bj][m][1];
                        float f[8] = {v0[0], v0[1], v0[2], v0[3], v1[0], v1[1], v1[2], v1[3]};
#pragma unroll
                        for (int i = 0; i < 8; ++i) { const float x = f[i]; const float sg = 1.f / (1.f + __expf(-x)); const float th = 1.f - 2.f / (1.f + __expf(2.f * x)); f[i] = sig ? sg : (bj == 0 ? th : x); }
                        u32x4 w; w.x = cvt_pk_bf16(f[0], f[1]); w.y = cvt_pk_bf16(f[2], f[3]); w.z = cvt_pk_bf16(f[4], f[5]); w.w = cvt_pk_bf16(f[6], f[7]);
                        *(u32x4*)(rowp + bj * HALF) = w; } }
        }
    }
};
template <class Epi, class Sched, bool ALIGN_EPI = false, bool SP2 = false, bool FP8 = false, bool GATHER = false>
__device__ __forceinline__ void gemm_phase(PG8_LAS unsigned char* lds, const Gemm g, const Sched& S, const Epi& E, const int wave_s) {
    int tid_ = (wave_s << 6) | (int)__builtin_amdgcn_mbcnt_hi(~0u, __builtin_amdgcn_mbcnt_lo(~0u, 0u)); asm volatile("" : "+v"(tid_));
    const int tid = tid_, wid = __builtin_amdgcn_readfirstlane(tid >> 6), lane = tid & 63, wr = wid >> 2, wc = wid & 3, fr = lane & 15, fq = lane >> 4;
    const int K = g.K, nt = K / BK;
    unsigned voffA[2], voffB[2];
#pragma unroll
    for (int i = 0; i < 2; ++i) { int R, C; stage_rc(tid * 16 + i * 8192, R, C); const int Rb = Epi::PERM ? ((R & ~31) + perm32(R & 31)) : R;
        voffA[i] = (unsigned)(R * g.lda + C) * 2u; voffB[i] = (unsigned)(Rb * K + C) * 2u; }
    unsigned gC[2] = {0u, 0u}, cg0[2] = {0u, 0u}, cg1[2] = {0u, 0u}, ng0[2] = {0u, 0u}, ng1[2] = {0u, 0u};
    if constexpr (GATHER) { static_assert(SP2, "GATHER is wired into the SP2 loop only");
#pragma unroll
        for (int i = 0; i < 2; ++i) { int R, C; stage_rc(tid * 16 + i * 8192, R, C); gC[i] = (unsigned)C * 2u; } }
    typedef int i32x16 __attribute__((ext_vector_type(16)));
#define PG8_GIDX(pm_, o0_, o1_) do { const int rb_ = (pm_) * BM + 16 * (wid >> 1); const int sel_ = lane >> 2; \
        _Pragma("unroll") for (int j_ = 0; j_ < 4; ++j_) { const i32x16 s_ = *(const __attribute__((address_space(4))) i32x16*)(g.gidx + rb_ + 64 * j_); int r_ = s_[0]; \
            _Pragma("unroll") for (int k_ = 1; k_ < 16; ++k_) r_ = (sel_ == k_) ? s_[k_] : r_; \
            const unsigned off_ = (unsigned)r_ * (unsigned)(g.lda * 2) + gC[j_ & 1]; if (j_ < 2) o0_[j_ & 1] = off_; else o1_[j_ & 1] = off_; } } while (0)
    const size_t kstep = (size_t)(BK * 2);
    const size_t hA = (size_t)HALF * g.lda * 2, hB = (size_t)HALF * K * 2;
    const size_t tA = 2 * hA, tB = 2 * hB;
    const unsigned ldsw = (unsigned)wid * 1024u;
    const int aoff = lds_byte(wr * 64 + fr, fq * 8), boff = lds_byte(wc * 32 + fr, fq * 8);
#define PG8_SA(b, h) (((b) * 2 + (h)) * HTB)
#define PG8_SB(b, h) ((4 + (b) * 2 + (h)) * HTB)
#define PG8_STAGE(bufoff, gbase, voff) do { _Pragma("unroll") for (int _i = 0; _i < 2; ++_i) \
        __builtin_amdgcn_global_load_lds((const unsigned*)((const char*)(gbase) + (voff)[_i]), (PG8_LAS unsigned*)(lds + (bufoff) + ldsw + _i * 8192), 16, 0, 0); } while (0)
#define PG8_LDA(dst, b, h) do { _Pragma("unroll") for (int m = 0; m < 4; ++m) _Pragma("unroll") for (int k = 0; k < 2; ++k) dst[m][k] = *(const PG8_LAS bf16x8*)(lds + PG8_SA(b, h) + aoff + m * 2048 + k * 1024); } while (0)
#define PG8_LDB(dst, b, h) do { _Pragma("unroll") for (int n = 0; n < 2; ++n) _Pragma("unroll") for (int k = 0; k < 2; ++k) dst[n][k] = *(const PG8_LAS bf16x8*)(lds + PG8_SB(b, h) + boff + n * 2048 + k * 1024); } while (0)
#define PG8_MMA(ai, bj, At, Bt) do { __builtin_amdgcn_s_setprio(1); _Pragma("unroll") for (int m = 0; m < 4; ++m) _Pragma("unroll") for (int n = 0; n < 2; ++n) _Pragma("unroll") for (int k = 0; k < 2; ++k) { \
        if constexpr (FP8) { typedef long l2_t __attribute__((ext_vector_type(2))); const l2_t b2_ = __builtin_bit_cast(l2_t, Bt[n][k]), a2_ = __builtin_bit_cast(l2_t, At[m][k]); \
            acc[ai][bj][m][n] = __builtin_amdgcn_mfma_f32_16x16x32_fp8_fp8(b2_[0], a2_[0], acc[ai][bj][m][n], 0, 0, 0); acc[ai][bj][m][n] = __builtin_amdgcn_mfma_f32_16x16x32_fp8_fp8(b2_[1], a2_[1], acc[ai][bj][m][n], 0, 0, 0); } \
        else acc[ai][bj][m][n] = __builtin_amdgcn_mfma_f32_16x16x32_bf16(Bt[n][k], At[m][k], acc[ai][bj][m][n], 0, 0, 0); } __builtin_amdgcn_s_setprio(0); } while (0)
#define PG8_WAIT_V(n) asm volatile("s_waitcnt vmcnt(" #n ")" ::: "memory")
#define PG8_WAIT_L(n) asm volatile("s_waitcnt lgkmcnt(" #n ")" ::: "memory")
#define PG8_BAR __builtin_amdgcn_s_barrier()
#define PG8_SCHED __builtin_amdgcn_sched_barrier(0)
    Unit cur, nxt; int ui = 0;
    if (!S.next(0, cur)) return;
    f32x4 acc[2][2][4][2];
#pragma unroll
    for (int a = 0; a < 2; ++a)
#pragma unroll
        for (int b = 0; b < 2; ++b)
#pragma unroll
            for (int m = 0; m < 4; ++m)
#pragma unroll
                for (int n = 0; n < 2; ++n) acc[a][b][m][n] = (f32x4){0.f, 0.f, 0.f, 0.f};
    bf16x8 At[4][2], B0[2][2], B1[2][2];
    const char* cA = (const char*)g.A + (GATHER ? (size_t)0 : (size_t)cur.pm * tA); if constexpr (GATHER) { PG8_GIDX(cur.pm, cg0, cg1); }
    const char* cB = (const char*)g.Bt + (size_t)(cur.pm / g.tpg) * g.bgs + (size_t)cur.pn * tB;
    S.a_ready(cur);
    if constexpr (SP2) {
        PG8_STAGE(PG8_SB(0, 0), cB, voffB); PG8_STAGE(PG8_SB(0, 1), cB + hB, voffB);
        if constexpr (GATHER) { PG8_STAGE(PG8_SA(0, 0), cA, cg0); PG8_STAGE(PG8_SA(0, 1), cA, cg1); } else { PG8_STAGE(PG8_SA(0, 0), cA, voffA); PG8_STAGE(PG8_SA(0, 1), cA + hA, voffA); }
        if (wr == 1) PG8_BAR;
        PG8_WAIT_V(2); PG8_BAR;
        PG8_STAGE(PG8_SB(1, 0), cB + kstep, voffB); if constexpr (GATHER) PG8_STAGE(PG8_SA(1, 0), cA + kstep, cg0); else PG8_STAGE(PG8_SA(1, 0), cA + kstep, voffA); PG8_STAGE(PG8_SB(1, 1), cB + hB + kstep, voffB);
        PG8_WAIT_V(6); PG8_BAR;
    } else {
        PG8_STAGE(PG8_SB(0, 0), cB, voffB); PG8_STAGE(PG8_SA(0, 0), cA, voffA); PG8_STAGE(PG8_SB(0, 1), cB + hB, voffB); PG8_STAGE(PG8_SA(0, 1), cA + hA, voffA);
        if (wr == 1) PG8_BAR;
        PG8_WAIT_V(4); PG8_BAR;
        PG8_STAGE(PG8_SB(1, 0), cB + kstep, voffB); PG8_STAGE(PG8_SA(1, 0), cA + kstep, voffA); PG8_STAGE(PG8_SB(1, 1), cB + hB + kstep, voffB);
        PG8_WAIT_V(6); PG8_BAR;
    }
    for (;;) {
        const bool has_next = S.next(ui + 1, nxt);
        if constexpr (GATHER) { if (has_next) { PG8_GIDX(nxt.pm, ng0, ng1); } else { ng0[0] = cg0[0]; ng0[1] = cg0[1]; ng1[0] = cg1[0]; ng1[1] = cg1[1]; } }
        const char* nA = GATHER ? cA : (has_next ? (const char*)g.A + (size_t)nxt.pm * tA : cA); const char* nB = has_next ? (const char*)g.Bt + (size_t)(nxt.pm / g.tpg) * g.bgs + (size_t)nxt.pn * tB : cB;
        for (int t = 0; t < nt; t += 2) {
            const bool last = (t == nt - 2);
            const char* a1 = cA + (size_t)(t + 1) * kstep;
            const char* a2 = last ? nA : cA + (size_t)(t + 2) * kstep; const char* b2 = last ? nB : cB + (size_t)(t + 2) * kstep;
            const char* a3 = a2 + kstep; const char* b3 = b2 + kstep;
            if (last && has_next) S.a_ready(nxt);
            if constexpr (SP2) {
            PG8_LDB(B0, 0, 0); PG8_LDB(B1, 0, 1); PG8_SCHED; PG8_LDA(At, 0, 0); if constexpr (GATHER) { PG8_STAGE(PG8_SA(1, 1), a1, cg1); if (last) { cg0[0] = ng0[0]; cg0[1] = ng0[1]; cg1[0] = ng1[0]; cg1[1] = ng1[1]; } }
            else PG8_STAGE(PG8_SA(1, 1), a1 + hA, voffA);
            PG8_WAIT_V(8); PG8_WAIT_L(0); PG8_BAR; PG8_MMA(0, 0, At, B0); PG8_MMA(0, 1, At, B1); PG8_BAR; PG8_SCHED;
            PG8_LDA(At, 0, 1); PG8_STAGE(PG8_SB(0, 0), b2, voffB); PG8_STAGE(PG8_SB(0, 1), b2 + hB, voffB); if constexpr (GATHER) PG8_STAGE(PG8_SA(0, 0), a2, cg0); else PG8_STAGE(PG8_SA(0, 0), a2, voffA);
            PG8_WAIT_V(8); PG8_WAIT_L(0); PG8_BAR; PG8_MMA(1, 0, At, B0); PG8_MMA(1, 1, At, B1); PG8_BAR; PG8_SCHED;
            PG8_LDB(B0, 1, 0); PG8_LDB(B1, 1, 1); PG8_SCHED; PG8_LDA(At, 1, 0); if constexpr (GATHER) PG8_STAGE(PG8_SA(0, 1), a2, cg1); else PG8_STAGE(PG8_SA(0, 1), a2 + hA, voffA);
            PG8_WAIT_V(8); PG8_WAIT_L(0); PG8_BAR; PG8_MMA(0, 0, At, B0); PG8_MMA(0, 1, At, B1); PG8_BAR; PG8_SCHED;
            PG8_LDA(At, 1, 1); PG8_STAGE(PG8_SB(1, 0), b3, voffB); PG8_STAGE(PG8_SB(1, 1), b3 + hB, voffB); if constexpr (GATHER) PG8_STAGE(PG8_SA(1, 0), a3, cg0); else PG8_STAGE(PG8_SA(1, 0), a3, voffA);
            PG8_WAIT_V(8); PG8_WAIT_L(0); PG8_BAR; PG8_MMA(1, 0, At, B0); PG8_MMA(1, 1, At, B1); PG8_BAR; PG8_SCHED;
            } else {
            PG8_LDB(B0, 0, 0); PG8_SCHED; PG8_LDA(At, 0, 0); PG8_STAGE(PG8_SA(1, 1), a1 + hA, voffA);
            PG8_WAIT_L(8); PG8_BAR; PG8_WAIT_L(0); PG8_MMA(0, 0, At, B0); PG8_BAR; PG8_SCHED;
            PG8_LDB(B1, 0, 1); PG8_STAGE(PG8_SB(0, 0), b2, voffB);
            PG8_BAR; PG8_WAIT_L(0); PG8_MMA(0, 1, At, B1); PG8_BAR;
            PG8_LDA(At, 0, 1); PG8_STAGE(PG8_SA(0, 0), a2, voffA);
            PG8_BAR; PG8_WAIT_L(0); PG8_MMA(1, 0, At, B0); PG8_BAR; PG8_SCHED;
            PG8_STAGE(PG8_SB(0, 1), b2 + hB, voffB);
            PG8_WAIT_V(6); PG8_BAR; PG8_MMA(1, 1, At, B1); PG8_BAR;
            PG8_LDB(B0, 1, 0); PG8_SCHED; PG8_LDA(At, 1, 0); PG8_STAGE(PG8_SA(0, 1), a2 + hA, voffA);
            PG8_WAIT_L(8); PG8_BAR; PG8_WAIT_L(0); PG8_MMA(0, 0, At, B0); PG8_BAR; PG8_SCHED;
            PG8_LDB(B1, 1, 1); PG8_STAGE(PG8_SB(1, 0), b3, voffB);
            PG8_BAR; PG8_WAIT_L(0); PG8_MMA(0, 1, At, B1); PG8_BAR;
            PG8_LDA(At, 1, 1); PG8_STAGE(PG8_SA(1, 0), a3, voffA);
            PG8_BAR; PG8_WAIT_L(0); PG8_MMA(1, 0, At, B0); PG8_BAR; PG8_SCHED;
            PG8_STAGE(PG8_SB(1, 1), b3 + hB, voffB);
            PG8_WAIT_V(6); PG8_BAR; PG8_MMA(1, 1, At, B1); PG8_BAR;
            }
        }
        if constexpr (ALIGN_EPI) { if (wr == 0) PG8_BAR; }
        if constexpr (!Epi::AFTER_DRAIN) { E(acc, cur, wr, wc, fr, fq); S.done(cur); }
        if (!has_next) break;
#pragma unroll
        for (int a = 0; a < 2; ++a)
#pragma unroll
            for (int b = 0; b < 2; ++b)
#pragma unroll
                for (int m = 0; m < 4; ++m)
#pragma unroll
                    for (int n = 0; n < 2; ++n) acc[a][b][m][n] = (f32x4){0.f, 0.f, 0.f, 0.f};
        cur = nxt; cA = nA; cB = nB; ++ui;
        if constexpr (ALIGN_EPI) { if (wr == 1) PG8_BAR; }
    }
    PG8_WAIT_V(0);
    if constexpr (!ALIGN_EPI) { if (wr == 0) PG8_BAR; }
    PG8_BAR;
    if constexpr (Epi::AFTER_DRAIN) { E.fused(acc, cur, wr, wc, fr, fq, lds, wid, lane); S.done(cur); }
#undef PG8_SA
#undef PG8_SB
#undef PG8_STAGE
#undef PG8_GIDX
#undef PG8_LDA
#undef PG8_LDB
#undef PG8_MMA
#undef PG8_WAIT_V
#undef PG8_WAIT_L
#undef PG8_BAR
#undef PG8_SCHED
}
}
#define GAS __attribute__((address_space(1)))
#define LAS __attribute__((address_space(3)))
typedef unsigned short bf16;
typedef unsigned v4u __attribute__((ext_vector_type(4)));
typedef unsigned v2u __attribute__((ext_vector_type(2)));
typedef float f32x4 __attribute__((ext_vector_type(4)));
typedef float f32x2 __attribute__((ext_vector_type(2)));
typedef GAS unsigned gu32;
#define RLX_AGENT __ATOMIC_RELAXED, __HIP_MEMORY_SCOPE_AGENT
#define LDS_WAIT() asm volatile("s_waitcnt lgkmcnt(0)" ::: "memory")
#define VM_WAIT() asm volatile("s_waitcnt vmcnt(0)" ::: "memory")

#define XB_TMO      128
#define XB_XCNT(j)  (256  + 64 * (j))
#define XB_XSUB(j)  (1280 + 64 * (j))
#define XB_XGEN(j)  (2304 + 64 * (j))
#define XB_TOP      3328
#define XB_TOPGEN   3392
#define XCD_BAR_WORDS 3456
#define XB_SPIN_CAP (1u << 18)

__device__ __forceinline__ unsigned xb_ld(unsigned* p)              { return __hip_atomic_load(p, __ATOMIC_RELAXED, __HIP_MEMORY_SCOPE_AGENT); }
__device__ __forceinline__ unsigned xb_add(unsigned* p, unsigned v) { return __hip_atomic_fetch_add(p, v, __ATOMIC_RELAXED, __HIP_MEMORY_SCOPE_AGENT); }
__device__ __forceinline__ unsigned xb_xcc_id() { return (unsigned)__builtin_amdgcn_s_getreg((3 << 11) | 20) & 0xFu; }
#define XB_SPIN(cond, bar) do { unsigned _sp = 0; while (cond) { __builtin_amdgcn_s_sleep(1); \
    if ((++_sp & 255u) == 0u) { if (xb_ld(&(bar)[XB_TMO])) break; if (_sp > XB_SPIN_CAP) { atomicAdd(&(bar)[XB_TMO], 1u); break; } } } } while (0)

struct XcdBarrier {
    unsigned* bar; unsigned x;
    volatile LAS unsigned* st;
};

__device__ __forceinline__ XcdBarrier xcd_barrier_post(unsigned* bar, volatile LAS unsigned* st) {
    XcdBarrier b; b.bar = bar; b.x = xb_xcc_id(); b.st = st;
    if (threadIdx.x == 0) (void)xb_add(&bar[XB_XCNT(b.x)], 1u);
    return b;
}
__device__ __forceinline__ void xcd_barrier_complete(unsigned* bar, unsigned x, unsigned& nloc, unsigned& nx) {
    const unsigned G = gridDim.x * gridDim.y * gridDim.z;
    unsigned sum, cnt, mine, sp = 0u;
    for (;;) {
        sum = 0u; cnt = 0u; mine = 0u;
#pragma unroll
        for (unsigned j = 0; j < 16; ++j) { const unsigned c = xb_ld(&bar[XB_XCNT(j)]); sum += c; cnt += (c > 0u) ? 1u : 0u; mine = (j == x) ? c : mine; }
        if (sum == G) break;
        __builtin_amdgcn_s_sleep(1);
        if ((++sp & 255u) == 0u) { if (xb_ld(&bar[XB_TMO])) break; if (sp > XB_SPIN_CAP) { atomicAdd(&bar[XB_TMO], 1u); break; } }
    }
    nloc = mine > 0u ? mine : 1u; nx = cnt > 0u ? cnt : 1u;
}

__device__ __forceinline__ void xcd_barrier(const XcdBarrier& b) {
    asm volatile("s_waitcnt vmcnt(0)" ::: "memory");
    __syncthreads();
    if (threadIdx.x == 0) {
        unsigned* bar = b.bar;
        __builtin_amdgcn_s_waitcnt(0);
        unsigned nloc = b.st[0], nx = b.st[1];
        if (nloc == 0u) { xcd_barrier_complete(bar, b.x, nloc, nx); b.st[0] = nloc; b.st[1] = nx; }
        const unsigned old = xb_add(&bar[XB_XSUB(b.x)], 1u);
        const unsigned gen = old / nloc;
        if (old + 1u == (gen + 1u) * nloc) {
            __builtin_amdgcn_fence(__ATOMIC_RELEASE, "agent");
            asm volatile("s_waitcnt vmcnt(0)" ::: "memory");
            const unsigned og = xb_add(&bar[XB_TOP], 1u);
            const unsigned tg = og / nx;
            if (og + 1u == (tg + 1u) * nx) xb_add(&bar[XB_TOPGEN], 1u);
            else XB_SPIN(xb_ld(&bar[XB_TOPGEN]) == tg, bar);
            __builtin_amdgcn_fence(__ATOMIC_ACQUIRE, "agent");
            xb_add(&bar[XB_XGEN(b.x)], 1u);
            asm volatile("s_waitcnt vmcnt(0)" ::: "memory");
        } else {
            XB_SPIN(xb_ld(&bar[XB_XGEN(b.x)]) == gen, bar);
            __builtin_amdgcn_fence(__ATOMIC_ACQUIRE, "agent");
            asm volatile("s_waitcnt vmcnt(0)" ::: "memory");
        }
    }
    __syncthreads();
}
constexpr int D = 1024, NB = 32, SEQ = 2048, CTXL = 256, NLAT = NB * SEQ, NCTX = NB * CTXL, NTOK = NLAT + NCTX;
constexpr int QW = 1792;
constexpr int NE = 16, NWAVES = 8, NTHR = 512, MODW = 6144;
constexpr size_t MiB = 1u << 20;
constexpr size_t WS_CTL = 0, WS_MOD = 1 * MiB, CTL_ZERO_BYTES = 3 * MiB;
constexpr size_t WS_ROPE = 3 * MiB;
constexpr size_t WS_AFFL = 4 * MiB, WS_AFFC = 8 * MiB;
constexpr size_t WS_STOK = 9 * MiB, WS_SGATE = 10 * MiB, WS_INV = 11 * MiB;
constexpr size_t WS_STOK1 = 13 * MiB + 512 * 1024;
constexpr size_t WS_COEF = 14 * MiB;
constexpr size_t WS_WIN = 22 * MiB, WS_WOUT = 26 * MiB, WS_WBIG = 28 * MiB, WS_WR = 40 * MiB, WS_G2 = 42 * MiB, WS_WO = 43 * MiB;
constexpr size_t WS_EW = 46 * MiB;
constexpr size_t WS_LORA = 46 * MiB;
constexpr size_t WS_XC = 238 * MiB;
constexpr size_t WS_H = 270 * MiB, WS_R1 = 414 * MiB, WS_R2 = 702 * MiB, WS_END = 990 * MiB;
constexpr int CW_BAR = 4096;
constexpr int CTRL_BASE = 146688, LDS_BYTES = 147456, MISC_OFF = CTRL_BASE, TAB_OFF = CTRL_BASE + 64;

__device__ __forceinline__ int opaque_tid(int wave_s) { int l; asm volatile("v_mbcnt_lo_u32_b32 %0, -1, 0\n\tv_mbcnt_hi_u32_b32 %0, -1, %0" : "=v"(l)); return (wave_s << 6) | l; }
typedef __bf16 bf16x2_t __attribute__((ext_vector_type(2)));
__device__ __forceinline__ unsigned pkbf(float lo, float hi) { const f32x2 v = {lo, hi}; const bf16x2_t b = __builtin_convertvector(v, bf16x2_t); return __builtin_bit_cast(unsigned, b); }
__device__ __forceinline__ float bflo(unsigned u) { return __uint_as_float(u << 16); }
__device__ __forceinline__ float bfhi(unsigned u) { return __uint_as_float(u & 0xffff0000u); }
__device__ __forceinline__ void unpack8(const v4u p, float (&f)[8]) { f[0] = bflo(p.x); f[1] = bfhi(p.x); f[2] = bflo(p.y); f[3] = bfhi(p.y); f[4] = bflo(p.z); f[5] = bfhi(p.z); f[6] = bflo(p.w); f[7] = bfhi(p.w); }
__device__ __forceinline__ v4u pack8(const float (&f)[8]) { v4u w; w.x = pkbf(f[0], f[1]); w.y = pkbf(f[2], f[3]); w.z = pkbf(f[4], f[5]); w.w = pkbf(f[6], f[7]); return w; }
__device__ __forceinline__ float sigmoidf_(float x) { return 1.f / (1.f + expf(-x)); }
__device__ __forceinline__ float sigmoid_fast(float x) { return __builtin_amdgcn_rcpf(1.f + __expf(-x)); }
__device__ __forceinline__ float softplusf_(float x) { return fmaxf(x, 0.f) + log1pf(expf(-fabsf(x))); }
__device__ __forceinline__ float gelu_tanh(float x) { return 0.5f * x * (1.f + tanhf(0.7978845608028654f * (x + 0.044715f * x * x * x))); }
template <int CTRL> __device__ __forceinline__ float dppmov(float v) { return __builtin_bit_cast(float, __builtin_amdgcn_update_dpp(0, __builtin_bit_cast(int, v), CTRL, 0xF, 0xF, true)); }
__device__ __forceinline__ float sum4(float v) { v += dppmov<0xB1>(v); v += dppmov<0x4E>(v); return v; }
__device__ __forceinline__ float rows_sum(float v) {
    float a = v, b;
    asm volatile("v_mov_b32 %1, %0\n\ts_nop 1\n\tv_permlane16_swap_b32 %0, %1\n\ts_nop 1" : "+v"(a), "=&v"(b));
    a += b;
    asm volatile("v_mov_b32 %1, %0\n\ts_nop 1\n\tv_permlane32_swap_b32 %0, %1\n\ts_nop 1" : "+v"(a), "=&v"(b));
    return a + b;
}
__device__ __forceinline__ float wave_sum(float v) {
    v += dppmov<0xB1>(v); v += dppmov<0x4E>(v); v += dppmov<0x141>(v); v += dppmov<0x140>(v);
    return rows_sum(v);
}
__device__ __forceinline__ int wave_sum_i(int v) {
    v += __builtin_amdgcn_update_dpp(0, v, 0xB1, 0xF, 0xF, true); v += __builtin_amdgcn_update_dpp(0, v, 0x4E, 0xF, 0xF, true); v += __builtin_amdgcn_update_dpp(0, v, 0x141, 0xF, 0xF, true); v += __builtin_amdgcn_update_dpp(0, v, 0x140, 0xF, 0xF, true);
    int a = v, b;
    asm volatile("v_mov_b32 %1, %0\n\ts_nop 1\n\tv_permlane16_swap_b32 %0, %1\n\ts_nop 1" : "+v"(a), "=&v"(b));
    a += b;
    asm volatile("v_mov_b32 %1, %0\n\ts_nop 1\n\tv_permlane32_swap_b32 %0, %1\n\ts_nop 1" : "+v"(a), "=&v"(b));
    return a + b;
}
__device__ __forceinline__ float sum8(float v) { v = sum4(v); v += dppmov<0x141>(v); return v; }

__device__ __forceinline__ void p_mods(const float* c, const float* cc, const float* mod_w, const float* mod_b, float* modacc, LAS unsigned char* lds, int bid, int G, int tid) {
    LAS float* S = (LAS float*)lds;
    const int wave = tid >> 6, lane = tid & 63;
    for (int it = bid; it < 192; it += G) {
        const int l = it / 96, n0 = (it % 96) * 64;
        __syncthreads();
        for (int i = tid; i < 33 * 1024; i += NTHR) { const int row = i >> 10, k = i & 1023; const float v = row < 32 ? c[row * 1024 + k] : cc[k]; S[i] = v / (1.f + expf(-v)); }
        __syncthreads();
        float acc[33];
#pragma unroll
        for (int row = 0; row < 33; ++row) acc[row] = 0.f;
        const float* W = mod_w + ((size_t)l * 1024 + wave * 128) * MODW + n0 + lane;
#pragma unroll 1
        for (int kb = 0; kb < 128; kb += 16) {
            float w[16];
#pragma unroll
            for (int i = 0; i < 16; ++i) w[i] = W[(size_t)(kb + i) * MODW];
#pragma unroll
            for (int i = 0; i < 16; i += 4) {
#pragma unroll
                for (int row = 0; row < 33; ++row) { const f32x4 s = *(const LAS f32x4*)(S + row * 1024 + wave * 128 + kb + i); acc[row] += s.x * w[i] + s.y * w[i + 1] + s.z * w[i + 2] + s.w * w[i + 3];
                    if (row % 6 == 5) asm volatile("" : "+v"(acc[row]) :: "memory"); } }
        }
        __syncthreads();
#pragma unroll
        for (int row = 0; row < 33; ++row) S[(wave * 33 + row) * 64 + lane] = acc[row];
        __syncthreads();
        for (int row = wave; row < 33; row += NWAVES) { float v = mod_b[l * MODW + n0 + lane];
#pragma unroll
            for (int j = 0; j < 8; ++j) v += S[(j * 33 + row) * 64 + lane];
            modacc[(size_t)(l * 33 + row) * MODW + n0 + lane] = v; }
    }
}
__device__ __forceinline__ void conv_items(const float* src, int K, int N, int nmat, size_t sms, bf16* dst, size_t dms, int pitch, int koff, int Kpad, int mode, int row_off,
                                           const float* mu, int smode, LAS float* scr, int gw, int NGW, int lane, int gstart, int& gcount, int variant = 0) {
    if ((N & 63) == 0) {
        const int nkb = Kpad / 64, nnb = N / 64, ipm = nkb * nnb, total = ipm * nmat; gcount = total;
        int first = (gw - gstart) % NGW; if (first < 0) first += NGW;
        for (int it = first; it < total; it += NGW) {
            const int mat = it / ipm, r = it % ipm, kb = r / nnb, nb = r % nnb, k0 = kb * 64, n0 = nb * 64;
            const float* W = src + (size_t)mat * sms; bf16* O = dst + (size_t)mat * dms;
            { f32x2 v[32]; const float* Wp = W + (size_t)(k0 + (lane >> 5)) * N + n0 + 2 * (lane & 31);
              if (variant == 2) {
#pragma unroll
                  for (int i = 0; i < 32; ++i) v[i] = (f32x2){0.f, 0.f};
              } else if (k0 + 64 <= K) {
#pragma unroll
                  for (int i = 0; i < 32; ++i) v[i] = *(const f32x2*)(Wp + (size_t)(2 * i) * N);
              } else {
#pragma unroll
                  for (int i = 0; i < 32; ++i) v[i] = (k0 + 2 * i + (lane >> 5) < K) ? *(const f32x2*)(Wp + (size_t)(2 * i) * N) : (f32x2){0.f, 0.f};
              }
              if (smode != 0) { const float* mp = mu + k0 + (lane >> 5);
#pragma unroll
                  for (int i = 0; i < 32; ++i) { const float mm = mp[2 * i]; v[i] *= (smode == 1) ? (1.f - mm) : mm; } }
#pragma unroll
              for (int i = 0; i < 32; ++i) { LAS float* sp = scr + (2 * i + (lane >> 5)) * 65 + 2 * (lane & 31); sp[0] = v[i].x; sp[1] = v[i].y; } }
            LDS_WAIT(); asm volatile("" ::: "memory");
            const int c = lane & 7;
#pragma unroll
            for (int j = 0; j < 8; ++j) { const int n = (lane >> 3) + 8 * j, gn = n0 + n; const int row = (mode == 0) ? row_off + gn : row_off + ((gn >> 7) << 8) + (((gn >> 2) & 1) << 7) + (((gn >> 5) & 3) << 5) + (((gn >> 3) & 3) << 3) + (gn & 3);
                const LAS float* s = scr + (8 * c) * 65 + n;
                v4u o; o.x = pkbf(s[0 * 65], s[1 * 65]); o.y = pkbf(s[2 * 65], s[3 * 65]); o.z = pkbf(s[4 * 65], s[5 * 65]); o.w = pkbf(s[6 * 65], s[7 * 65]);
                if (variant != 1 || o.x == 0x12345678u) *(v4u*)(O + (size_t)row * pitch + koff + k0 + 8 * c) = o; }
            LDS_WAIT(); asm volatile("" ::: "memory");
        }
        return;
    }
    const int nkb = Kpad / 64, nnb = N / 32, ipm = nkb * nnb, total = ipm * nmat; gcount = total;
    int first = (gw - gstart) % NGW; if (first < 0) first += NGW;
    for (int it = first; it < total; it += NGW) {
        const int mat = it / ipm, r = it % ipm, kb = r / nnb, nb = r % nnb, k0 = kb * 64, n0 = nb * 32;
        const float* W = src + (size_t)mat * sms; bf16* O = dst + (size_t)mat * dms;
        { float v[32]; const float* Wp = W + (size_t)(k0 + (lane >> 5)) * N + n0 + (lane & 31);
          if (k0 + 64 <= K) {
#pragma unroll
              for (int i = 0; i < 32; ++i) v[i] = Wp[(size_t)(2 * i) * N];
          } else {
#pragma unroll
              for (int i = 0; i < 32; ++i) v[i] = (k0 + 2 * i + (lane >> 5) < K) ? Wp[(size_t)(2 * i) * N] : 0.f;
          }
          if (smode != 0) { const float* mp = mu + k0 + (lane >> 5);
#pragma unroll
              for (int i = 0; i < 32; ++i) { const float mm = mp[2 * i]; v[i] *= (smode == 1) ? (1.f - mm) : mm; } }
#pragma unroll
          for (int i = 0; i < 32; ++i) scr[(2 * i + (lane >> 5)) * 33 + (lane & 31)] = v[i]; }
        LDS_WAIT(); asm volatile("" ::: "memory");
        const int c = lane & 7;
#pragma unroll
        for (int j = 0; j < 4; ++j) { const int n = (lane >> 3) + 8 * j, gn = n0 + n; const int row = (mode == 0) ? row_off + gn : row_off + ((gn >> 7) << 8) + (((gn >> 2) & 1) << 7) + (((gn >> 5) & 3) << 5) + (((gn >> 3) & 3) << 3) + (gn & 3);
            const LAS float* s = scr + (8 * c) * 33 + n;
            v4u o; o.x = pkbf(s[0 * 33], s[1 * 33]); o.y = pkbf(s[2 * 33], s[3 * 33]); o.z = pkbf(s[4 * 33], s[5 * 33]); o.w = pkbf(s[6 * 33], s[7 * 33]);
            *(v4u*)(O + (size_t)row * pitch + koff + k0 + 8 * c) = o; }
        LDS_WAIT(); asm volatile("" ::: "memory");
    }
}

__device__ __forceinline__ void conv_block_items(const float* src, int K, int N, int nmat, size_t sms, bf16* dst, size_t dms, int pitch, int koff, int mode, int row_off,
                                                 const float* mu, int smode, LAS unsigned char* lds, int bid, int G, int tid, int gstart, int& gcount) {
    const int nkb = K / 256, nnb = N / 256, ipm = nkb * nnb, total = ipm * nmat; gcount = total;
    int first = (bid - gstart) % G; if (first < 0) first += G;
    const int wave = tid >> 6, lane = tid & 63;
    for (int it = first; it < total; it += G) {
        const int mat = it / ipm, r = it % ipm, kb = r / nnb, nb = r % nnb, k0 = kb * 256, n0 = nb * 256;
        const float* W = src + (size_t)mat * sms + (size_t)k0 * N + n0; bf16* O = dst + (size_t)mat * dms;
        __syncthreads();
#pragma unroll
        for (int hp = 0; hp < 2; ++hp) { f32x4 a[8], b[8];
#pragma unroll
            for (int i = 0; i < 8; ++i) { const int k = 32 * wave + 2 * (8 * hp + i); a[i] = *(const f32x4*)(W + (size_t)k * N + 4 * lane); b[i] = *(const f32x4*)(W + (size_t)(k + 1) * N + 4 * lane); }
#pragma unroll
            for (int i = 0; i < 8; ++i) { const int k = 32 * wave + 2 * (8 * hp + i); float sa = 1.f, sb = 1.f;
                if (smode != 0) { const float ma = mu[k0 + k], mb = mu[k0 + k + 1]; sa = (smode == 1) ? 1.f - ma : ma; sb = (smode == 1) ? 1.f - mb : mb; }
                LAS unsigned char* tp = lds + (4 * lane) * 516 + k * 2;
                *(LAS unsigned*)(tp) = pkbf(a[i].x * sa, b[i].x * sb); *(LAS unsigned*)(tp + 516) = pkbf(a[i].y * sa, b[i].y * sb);
                *(LAS unsigned*)(tp + 1032) = pkbf(a[i].z * sa, b[i].z * sb); *(LAS unsigned*)(tp + 1548) = pkbf(a[i].w * sa, b[i].w * sb); } }
        __syncthreads();
#pragma unroll 4
        for (int j = 0; j < 16; ++j) { const int n = 16 * j + (tid >> 5), c = tid & 31, gn = n0 + n;
            const int row = (mode == 0) ? row_off + gn : row_off + ((gn >> 7) << 8) + (((gn >> 2) & 1) << 7) + (((gn >> 5) & 3) << 5) + (((gn >> 3) & 3) << 3) + (gn & 3);
            const LAS unsigned char* sp = lds + n * 516 + c * 16;
            v4u o; o.x = *(const LAS unsigned*)(sp); o.y = *(const LAS unsigned*)(sp + 4); o.z = *(const LAS unsigned*)(sp + 8); o.w = *(const LAS unsigned*)(sp + 12);
            *(v4u*)(O + (size_t)row * pitch + koff + k0 + 8 * c) = o; }
    }
    __syncthreads();
}

__device__ __forceinline__ void load_row(const float* src, int lane, f32x4 (&v)[4]) {
#pragma unroll
    for (int j = 0; j < 4; ++j) v[j] = *(const f32x4*)(src + 4 * lane + 256 * j);
}
__device__ __forceinline__ float row_rstd(const f32x4 (&v)[4]) {
    float s = 0.f;
#pragma unroll
    for (int j = 0; j < 4; ++j) s += (v[j].x * v[j].x + v[j].y * v[j].y) + (v[j].z * v[j].z + v[j].w * v[j].w);
    return rsqrtf(wave_sum(s) * (1.f / 1024.f) + 1e-6f);
}
__device__ __forceinline__ void modulate_row(const f32x4 (&v)[4], float rstd, const float* g, const float* shift, const float* scale, int lane, f32x4 (&h)[4]) {
#pragma unroll
    for (int j = 0; j < 4; ++j) { const int col = 4 * lane + 256 * j; const f32x4 gg = *(const f32x4*)(g + col), sh = *(const f32x4*)(shift + col), sc = *(const f32x4*)(scale + col);
        h[j] = v[j] * rstd * gg * (sc + 1.f) + sh; }
}
__device__ __forceinline__ void store_row_bf16(const f32x4 (&h)[4], bf16* dst, int lane) {
#pragma unroll
    for (int j = 0; j < 4; ++j) { v2u w; w.x = pkbf(h[j].x, h[j].y); w.y = pkbf(h[j].z, h[j].w); *(v2u*)(dst + 4 * lane + 256 * j) = w; }
}

__device__ __forceinline__ void p_norm0(const float* x, const float* ctx, const float* nw, const float* modl, bf16* H, int gw, int NGW, int lane) {
    f32x4 va[4], vb[4];
#define N0_SRC(r_) ((r_) >= NLAT ? ctx + (size_t)((r_) - NLAT) * D : x + (size_t)(r_) * D)
#define N0_STEP(CUR_, r_) do { const int rw_ = (r_); if (rw_ < NTOK) { const bool isc = rw_ >= NLAT; const int gb = isc ? 32 : rw_ >> 11; const float* m = modl + (size_t)gb * MODW; \
        f32x4 v[4], h[4]; _Pragma("unroll") for (int j = 0; j < 4; ++j) v[j] = CUR_[j]; \
        { const int rn = rw_ + 2 * NGW; if (rn < NTOK) load_row(N0_SRC(rn), lane, CUR_); } \
        const float rstd = row_rstd(v); modulate_row(v, rstd, nw, m, m + 1024, lane, h); store_row_bf16(h, H + (size_t)rw_ * D, lane); } } while (0)
    if (gw < NTOK) load_row(N0_SRC(gw), lane, va);
    if (gw + NGW < NTOK) load_row(N0_SRC(gw + NGW), lane, vb);
#pragma unroll 1
    for (int row = gw; row < NTOK; row += 2 * NGW) { N0_STEP(va, row); N0_STEP(vb, row + NGW); }
#undef N0_STEP
#undef N0_SRC
}

typedef short bf16x8 __attribute__((ext_vector_type(8)));
typedef short short4v __attribute__((ext_vector_type(4)));
__device__ __forceinline__ void p_attn(const bf16* QKV, const float* rope, const float* sink, bf16* CAT, LAS unsigned char* lds, int bid, int G, int tid) {
    constexpr int PB = 144, TB = 64 * PB, PV = 160, BUFB = TB + 64 * PV;
    constexpr float L2E = 1.4426950408889634f, QS = 0.125f * L2E;
    const int wave = tid >> 6, lane = tid & 63, n16 = lane & 15, g = lane >> 4;
    const int skey = tid >> 3, sc = tid & 7;
    const LAS float* ropeL = (const LAS float*)(lds + 2 * BUFB);
    __syncthreads();
    for (int i = tid; i < 96 * 32; i += NTHR) ((LAS float*)(lds + 2 * BUFB))[i] = rope[i];
    __syncthreads();
    const int nxu = (G % 8 == 0) ? 2304 / 8 : 0, gpx = G / 8;
    for (int ui = 0;; ++ui) {
        int u; if (nxu) { const int w = ui * gpx + (bid >> 3); if (w >= nxu) break; u = (w < 256) ? (bid & 7) * 256 + w : 2048 + (bid & 7) * 32 + (w - 256); } else { u = ui * G + bid; if (u >= 2304) break; }
        const bool cq = u >= 2048; int b, kvh, qb;
        if (!cq) { b = u >> 6; kvh = (u >> 5) & 1; qb = u & 31; } else { const int uu = u - 2048; b = uu >> 3; kvh = (uu >> 2) & 1; qb = uu & 3; }
        const int hq = kvh * 4 + (wave & 3), sb = wave >> 2, tq0 = qb * 64 + sb * 32;
        const size_t qrow0 = (cq ? (size_t)NLAT + b * CTXL : (size_t)b * SEQ) + tq0;
        struct KSet { v4u k, p, v; bool valid, win; int tk; };
#define ATT_LOAD(t_, S_) do { const int tt_ = (t_) < ntile ? (t_) : ntile - 1; S_.win = tt_ >= 4; const int tk0_ = S_.win ? qb * 64 - 128 + (tt_ - 4) * 64 : tt_ * 64; S_.tk = tk0_ + skey; S_.valid = !S_.win || (S_.tk >= 0 && S_.tk < SEQ); \
              \
            { const int tkc_ = S_.tk < 0 ? 0 : (S_.tk >= SEQ ? SEQ - 1 : S_.tk); const size_t krow_ = S_.win ? (size_t)b * SEQ + tkc_ : (size_t)NLAT + b * CTXL + S_.tk; const bf16* kp_ = QKV + krow_ * QW + 512 + kvh * 64; \
                S_.k = *(const v4u*)(kp_ + sc * 8); S_.v = *(const v4u*)(kp_ + 128 + sc * 8); S_.p = *(const v4u*)(kp_ + (sc ^ 2) * 8); } } while (0)
        const int ntile = cq ? 4 : 9;
        KSet sA; ATT_LOAD(0, sA);
        bf16x8 qf[2][2];
#pragma unroll
        for (int qt = 0; qt < 2; ++qt)
#pragma unroll
            for (int kk = 0; kk < 2; ++kk) { const int tq = tq0 + qt * 16 + n16; const bf16* qp = QKV + (qrow0 + qt * 16 + n16) * QW + hq * 64 + kk * 32;
                float f[8]; unpack8(*(const v4u*)(qp + 8 * g), f);
                if (!cq) { float pf[8]; unpack8(*(const v4u*)(qp + 8 * (g ^ 2)), pf); const LAS float* tb = ropeL + (kk == 0 ? (tq >> 6) : 32 + (tq & 63)) * 32 + (g & 1) * 16;
#pragma unroll
                    for (int j = 0; j < 8; ++j) { const float cs = tb[2 * j], sn = tb[2 * j + 1]; f[j] = (g & 2) ? (f[j] * cs + pf[j] * sn) : (f[j] * cs - pf[j] * sn); } }
#pragma unroll
                for (int j = 0; j < 8; ++j) f[j] *= QS;
                qf[qt][kk] = __builtin_bit_cast(bf16x8, pack8(f)); }
        f32x4 ot[4][2];
#pragma unroll
        for (int dt = 0; dt < 4; ++dt) { ot[dt][0] = (f32x4){0.f, 0.f, 0.f, 0.f}; ot[dt][1] = (f32x4){0.f, 0.f, 0.f, 0.f}; }
        const float sk2 = sink[hq] * L2E;
        float m_[2] = {sk2, sk2}; f32x4 lacc[2] = {(f32x4){1.f, 1.f, 1.f, 1.f}, (f32x4){1.f, 1.f, 1.f, 1.f}};
        const bf16x8 ones8 = __builtin_bit_cast(bf16x8, (v4u){0x3f803f80u, 0x3f803f80u, 0x3f803f80u, 0x3f803f80u});
#define ATT_STORE(buf_, S_) do { LAS unsigned char* kb_ = lds + (buf_) * BUFB; v4u kw_ = (v4u){0u, 0u, 0u, 0u}; v4u vw_ = kw_; \
            asm volatile("" : "+v"(S_.k), "+v"(S_.v), "+v"(S_.p));        \
            if (S_.valid) { vw_ = S_.v; kw_ = S_.k; if (S_.win) { float kf_[8], pf_[8]; unpack8(S_.k, kf_); unpack8(S_.p, pf_); const LAS float* tb_ = ropeL + ((sc < 4) ? (S_.tk >> 6) : 32 + (S_.tk & 63)) * 32 + (sc & 1) * 16; \
                _Pragma("unroll") for (int j = 0; j < 8; ++j) { const float cs = tb_[2 * j], sn = tb_[2 * j + 1]; kf_[j] = (sc & 2) ? (kf_[j] * cs + pf_[j] * sn) : (kf_[j] * cs - pf_[j] * sn); } kw_ = pack8(kf_); } } \
            *(LAS v4u*)(kb_ + skey * PB + sc * 16) = kw_; \
            *(LAS v4u*)(kb_ + TB + skey * PV + sc * 16) = vw_; } while (0)
        auto att_qk = [&](const int buf, f32x4 (&S)[2][4]) __attribute__((always_inline)) { const LAS unsigned char* Kb = lds + buf * BUFB;
#pragma unroll
            for (int s = 0; s < 4; ++s) { const bf16x8 k0 = *(const LAS bf16x8*)(Kb + (s * 16 + n16) * PB + g * 16), k1 = *(const LAS bf16x8*)(Kb + (s * 16 + n16) * PB + 64 + g * 16);
#pragma unroll
                for (int qt = 0; qt < 2; ++qt) { S[qt][s] = __builtin_amdgcn_mfma_f32_16x16x32_bf16(k0, qf[qt][0], (f32x4){0.f, 0.f, 0.f, 0.f}, 0, 0, 0);
                    S[qt][s] = __builtin_amdgcn_mfma_f32_16x16x32_bf16(k1, qf[qt][1], S[qt][s], 0, 0, 0); } } };
        ATT_STORE(0, sA); ATT_LOAD(1, sA);
        __syncthreads();
#pragma unroll 1
        for (int t = 0; t < ntile; ++t) {
            const bool win = t >= 4; const int tk0 = win ? qb * 64 - 128 + (t - 4) * 64 : t * 64;
            const LAS unsigned char* Vb = lds + (t & 1) * BUFB + TB + (4 * g + (n16 >> 2)) * PV + (n16 & 3) * 8;
            f32x4 st[2][4];
            att_qk(t & 1, st);
            if (win && (tk0 < tq0 - 97 || tk0 + 63 > tq0 + 128 || tk0 < 0 || tk0 + 63 >= SEQ)) {
#pragma unroll
                for (int qt = 0; qt < 2; ++qt) { const int tq = tq0 + qt * 16 + n16;
#pragma unroll
                    for (int s = 0; s < 4; ++s)
#pragma unroll
                        for (int j = 0; j < 4; ++j) { const int tk = tk0 + s * 16 + 4 * g + j, dl = tk - tq; const bool ok = (tk >= 0) && (tk < SEQ) && (dl <= 128) && (dl >= -128); st[qt][s][j] = ok ? st[qt][s][j] : -1e30f; } }
            }
            bf16x8 pfr[2][2];
#pragma unroll
            for (int qt = 0; qt < 2; ++qt) {
                f32x4 d[4];
#pragma unroll
                for (int s = 0; s < 4; ++s) d[s] = st[qt][s] - m_[qt];
                float mx = fmaxf(fmaxf(d[0][0], d[0][1]), fmaxf(d[0][2], d[0][3]));
#pragma unroll
                for (int s = 1; s < 4; ++s) mx = fmaxf(mx, fmaxf(fmaxf(d[s][0], d[s][1]), fmaxf(d[s][2], d[s][3])));
                if (__any(mx > 8.f)) {
                    float gm = fmaxf(mx, __shfl_xor(mx, 16)); gm = fmaxf(gm, __shfl_xor(gm, 32)); gm = fmaxf(gm, 0.f);
                    const float corr = __builtin_amdgcn_exp2f(-gm); m_[qt] += gm; lacc[qt] *= corr;
#pragma unroll
                    for (int s = 0; s < 4; ++s) d[s] -= gm;
#pragma unroll
                    for (int dt = 0; dt < 4; ++dt) ot[dt][qt] *= corr; }
                float pe[4][4];
#pragma unroll
                for (int s = 0; s < 4; ++s)
#pragma unroll
                    for (int j = 0; j < 4; ++j) pe[s][j] = __builtin_amdgcn_exp2f(d[s][j]);
#pragma unroll
                for (int pr = 0; pr < 2; ++pr) { v4u w; w.x = pkbf(pe[2 * pr][0], pe[2 * pr][1]); w.y = pkbf(pe[2 * pr][2], pe[2 * pr][3]); w.z = pkbf(pe[2 * pr + 1][0], pe[2 * pr + 1][1]); w.w = pkbf(pe[2 * pr + 1][2], pe[2 * pr + 1][3]);
                    pfr[qt][pr] = __builtin_bit_cast(bf16x8, w); }
            }
#pragma unroll
            for (int dt = 0; dt < 4; ++dt)
#pragma unroll
                for (int pr = 0; pr < 2; ++pr) {
                    const short4v v0 = __builtin_amdgcn_ds_read_tr16_b64_v4i16((LAS short4v*)(Vb + pr * 32 * PV + dt * 32)), v1 = __builtin_amdgcn_ds_read_tr16_b64_v4i16((LAS short4v*)(Vb + pr * 32 * PV + 16 * PV + dt * 32));
                    const bf16x8 vf = __builtin_shufflevector(v0, v1, 0, 1, 2, 3, 4, 5, 6, 7);
                    ot[dt][0] = __builtin_amdgcn_mfma_f32_16x16x32_bf16(vf, pfr[0][pr], ot[dt][0], 0, 0, 0); ot[dt][1] = __builtin_amdgcn_mfma_f32_16x16x32_bf16(vf, pfr[1][pr], ot[dt][1], 0, 0, 0); }
#pragma unroll
            for (int pr = 0; pr < 2; ++pr) { lacc[0] = __builtin_amdgcn_mfma_f32_16x16x32_bf16(ones8, pfr[0][pr], lacc[0], 0, 0, 0); lacc[1] = __builtin_amdgcn_mfma_f32_16x16x32_bf16(ones8, pfr[1][pr], lacc[1], 0, 0, 0); }
            ATT_STORE((t + 1) & 1, sA);
            ATT_LOAD(t + 2, sA);
            asm volatile("s_waitcnt lgkmcnt(0)" ::: "memory"); __builtin_amdgcn_s_barrier(); asm volatile("" ::: "memory");
        }
#undef ATT_LOAD
#undef ATT_STORE
#pragma unroll
        for (int qt = 0; qt < 2; ++qt) { const float inv = 1.f / lacc[qt][0];
            bf16* op = CAT + (qrow0 + qt * 16 + n16) * D + hq * 64 + 4 * g;
#pragma unroll
            for (int dt = 0; dt < 4; ++dt) { v2u w; w.x = pkbf(ot[dt][qt][0] * inv, ot[dt][qt][1] * inv); w.y = pkbf(ot[dt][qt][2] * inv, ot[dt][qt][3] * inv); *(v2u*)(op + dt * 16) = w; } }
    }
}

template <int CTRL> __device__ __forceinline__ float dppz(float v) { return __builtin_bit_cast(float, __builtin_amdgcn_update_dpp(0, __builtin_bit_cast(int, v), CTRL, 0xF, 0xF, true)); }
template <int CTRL> __device__ __forceinline__ float dpp_old(float old, float v) { return __builtin_bit_cast(float, __builtin_amdgcn_update_dpp(__builtin_bit_cast(int, old), __builtin_bit_cast(int, v), CTRL, 0xF, 0xF, false)); }
__device__ __forceinline__ float tanh_fast(float x) { return 1.f - 2.f * __builtin_amdgcn_rcpf(1.f + __expf(2.f * x)); }
__device__ __forceinline__ float gelu_fast(float x) { return 0.5f * x * (1.f + tanh_fast(0.7978845608028654f * (x + 0.044715f * x * x * x))); }
__device__ __forceinline__ void p_lru(const bf16* QKV, const float* conv_w, const float* conv_b, const float* wa, const float* ba, const float* wi, const float* bi, const float* lam,
                                      float* YB, bf16* CAT, LAS unsigned char* lds, int bid, int G, int tid, int variant = 0) {
    constexpr int TP = 144, TILE = 16 * TP;
    const int wave = tid >> 6, lane = tid & 63, n16 = lane & 15, g = lane >> 4, dir = wave & 1, mt = wave >> 1;
    const int tl = dir ? 15 - n16 : n16;
    const int s_tile = tid >> 8, s_tok = (tid >> 4) & 15, s_c4 = (tid & 15) * 4;
    const f32x4 zero4 = (f32x4){0.f, 0.f, 0.f, 0.f};
    for (int u = bid; u < 256; u += G) {
        const int b = u >> 3, cb = u & 7;
        bf16x8 waf[2], wif[2];
#pragma unroll
        for (int kk = 0; kk < 2; ++kk) { float fa[8], fi[8];
#pragma unroll
            for (int i = 0; i < 8; ++i) { const size_t o = ((size_t)(dir * 8 + cb) * 64 + 32 * kk + 8 * g + i) * 64 + 16 * mt + n16; fa[i] = wa[o]; fi[i] = wi[o]; }
            waf[kk] = __builtin_bit_cast(bf16x8, pack8(fa)); wif[kk] = __builtin_bit_cast(bf16x8, pack8(fi)); }
        float gba[4], gbi[4], sp8[4], hin[4];
#pragma unroll
        for (int j = 0; j < 4; ++j) { const int c = dir * 512 + cb * 64 + 16 * mt + 4 * g + j; gba[j] = ba[c]; gbi[j] = bi[c]; sp8[j] = 8.f * 1.4426950408889634f * softplusf_(-lam[c]); hin[j] = 0.f; }
        float cw[4][4], cbias[4];
#pragma unroll
        for (int i = 0; i < 4; ++i) { cbias[i] = conv_b[cb * 64 + s_c4 + i];
#pragma unroll
            for (int j = 0; j < 4; ++j) cw[j][i] = conv_w[j * 512 + cb * 64 + s_c4 + i]; }
        v2u tp0[4], tp1[4], tp2[4], tp3[4]; f32x4 o0 = zero4, o1 = zero4, o2 = zero4, o3 = zero4; v2u g0 = (v2u){0u, 0u}, g1 = g0, g2 = g0, g3 = g0;
#define LRU_TAPS(kn_, tp_) do { const int kn = (kn_); const bool isc_ = kn < 16; const int gi_ = isc_ ? (s_tile ? 15 - kn : kn) : (s_tile ? 143 - kn : kn - 16); \
            const int t_ = gi_ * 16 + s_tok, len_ = isc_ ? CTXL : SEQ; const size_t rb_ = isc_ ? (size_t)NLAT + b * CTXL : (size_t)b * SEQ; \
            _Pragma("unroll") for (int j = 0; j < 4; ++j) { const int ts = t_ - 2 + j; tp_[j] = (ts >= 0 && ts < len_) ? *(const v2u*)(QKV + (rb_ + ts) * QW + 768 + cb * 64 + s_c4) : (v2u){0u, 0u}; } } while (0)
#define LRU_CONV(kn_, tp_) do { float a_[4] = {cbias[0], cbias[1], cbias[2], cbias[3]}; \
            _Pragma("unroll") for (int j = 0; j < 4; ++j) { a_[0] += bflo(tp_[j].x) * cw[j][0]; a_[1] += bfhi(tp_[j].x) * cw[j][1]; a_[2] += bflo(tp_[j].y) * cw[j][2]; a_[3] += bfhi(tp_[j].y) * cw[j][3]; } \
            v2u w_; w_.x = pkbf(a_[0], a_[1]); w_.y = pkbf(a_[2], a_[3]); *(LAS v2u*)(lds + (((kn_) & 1) * 2 + s_tile) * TILE + s_tok * TP + s_c4 * 2) = w_; } while (0)
#define LRU_ROW(k_, out_) do { const int kq = (k_); const bool isc_ = kq < 16; const int gi_ = isc_ ? (dir ? 15 - kq : kq) : (dir ? 143 - kq : kq - 16); out_ = (isc_ ? (size_t)NLAT + b * CTXL : (size_t)b * SEQ) + gi_ * 16 + tl; } while (0)
#define LRU_FIN(k_) (((k_) < 16) ? ((k_) >= 8) : ((k_) >= 80))
#define LRU_OG(kq_, o_, g_) do { size_t rn_; LRU_ROW(kq_, rn_); o_ = *(const f32x4*)(YB + ((size_t)(1 - dir) * NTOK + rn_) * 512 + cc); g_ = *(const v2u*)(QKV + rn_ * QW + 1280 + cc); } while (0)
        const int cc = cb * 64 + 16 * mt + 4 * g;
        const float oob[4] = {n16 < 1 ? 1.f : 0.f, n16 < 2 ? 1.f : 0.f, n16 < 4 ? 1.f : 0.f, n16 < 8 ? 1.f : 0.f};
        __syncthreads();
        LRU_TAPS(0, tp0); LRU_CONV(0, tp0); LRU_TAPS(1, tp1); LRU_TAPS(2, tp2); LRU_TAPS(3, tp3);
        __syncthreads();
#define LRU_STEP(k_, oU, gU, oL, gL, tC, tL) do { const int k = (k_); if (variant != 1) { \
            if (k == 8 || k == 80) { LRU_OG(k, oU, gU);   } \
            { const int kn = k + 3; if (kn < 144 && LRU_FIN(kn) && (kn < 16 ? k >= 8 : k >= 80)) LRU_OG(kn, oL, gL); } \
            if (k == 8 || k == 80) { if (LRU_FIN(k + 1)) LRU_OG(k + 1, o_x1, g_x1); if (LRU_FIN(k + 2)) LRU_OG(k + 2, o_x2, g_x2); } \
            size_t row; LRU_ROW(k, row); const bool fin = LRU_FIN(k); \
            if (k + 1 < 144) { LRU_CONV(k + 1, tC); if (k + 4 < 144) LRU_TAPS(k + 4, tL); } \
            { const LAS unsigned char* ut = lds + ((k & 1) * 2 + dir) * TILE + tl * TP; \
              const bf16x8 uf0 = *(const LAS bf16x8*)(ut + g * 16), uf1 = *(const LAS bf16x8*)(ut + 64 + g * 16); \
              f32x4 pr = __builtin_amdgcn_mfma_f32_16x16x32_bf16(waf[0], uf0, zero4, 0, 0, 0); pr = __builtin_amdgcn_mfma_f32_16x16x32_bf16(waf[1], uf1, pr, 0, 0, 0); \
              f32x4 pi = __builtin_amdgcn_mfma_f32_16x16x32_bf16(wif[0], uf0, zero4, 0, 0, 0); pi = __builtin_amdgcn_mfma_f32_16x16x32_bf16(wif[1], uf1, pi, 0, 0, 0); \
              const v2u up = *(const LAS v2u*)(ut + (16 * mt + 4 * g) * 2); \
              const float uu[4] = {bflo(up.x), bfhi(up.x), bflo(up.y), bfhi(up.y)}; \
              float h[4]; \
              _Pragma("unroll") for (int j = 0; j < 4; ++j) { \
                  const float r = sigmoid_fast(pr[j] + gba[j]), ig = sigmoid_fast(pi[j] + gbi[j]); \
                  float A = __builtin_amdgcn_exp2f(-r * sp8[j]); float B = __builtin_amdgcn_sqrtf(fmaxf(1.f - A * A, 0.f)) * ig * uu[j]; \
                    \
                  { const float Ap = dppz<0x111>(A) + oob[0], Bp = dppz<0x111>(B); B = A * Bp + B; A = A * Ap; } \
                  { const float Ap = dppz<0x112>(A) + oob[1], Bp = dppz<0x112>(B); B = A * Bp + B; A = A * Ap; } \
                  { const float Ap = dppz<0x114>(A) + oob[2], Bp = dppz<0x114>(B); B = A * Bp + B; A = A * Ap; } \
                  { const float Ap = dppz<0x118>(A) + oob[3], Bp = dppz<0x118>(B); B = A * Bp + B; A = A * Ap; } \
                  h[j] = A * hin[j] + B; hin[j] = __shfl(h[j], (lane & 48) | 15); } \
              if (!fin) *(f32x4*)(YB + ((size_t)dir * NTOK + row) * 512 + cc) = (f32x4){h[0], h[1], h[2], h[3]}; \
              else { v2u w; w.x = pkbf((h[0] + oU.x) * gelu_fast(bflo(gU.x)), (h[1] + oU.y) * gelu_fast(bfhi(gU.x))); w.y = pkbf((h[2] + oU.z) * gelu_fast(bflo(gU.y)), (h[3] + oU.w) * gelu_fast(bfhi(gU.y))); \
                  *(v2u*)(CAT + row * D + 512 + cc) = w; } } } \
            if (k == 7 || k == 79) __syncthreads();        \
            else { asm volatile("s_waitcnt lgkmcnt(0)" ::: "memory"); __builtin_amdgcn_s_barrier(); asm volatile("" ::: "memory"); }        \
        } while (0)
#pragma unroll 1
        for (int k4 = 0; k4 < 144; k4 += 4) {
#define o_x1 o1
#define g_x1 g1
#define o_x2 o2
#define g_x2 g2
            LRU_STEP(k4 + 0, o0, g0, o3, g3, tp1, tp0);
            LRU_STEP(k4 + 1, o1, g1, o0, g0, tp2, tp1);
            LRU_STEP(k4 + 2, o2, g2, o1, g1, tp3, tp2);
            LRU_STEP(k4 + 3, o3, g3, o2, g2, tp0, tp3);
#undef o_x1
#undef g_x1
#undef o_x2
#undef g_x2
        }
#undef LRU_STEP
#undef LRU_OG
#undef LRU_TAPS
#undef LRU_CONV
#undef LRU_ROW
#undef LRU_FIN
    }
}
__device__ __forceinline__ void p_norm_router(const bf16* XL, const bf16* XC, int nrows, const float* nw, const float* modl, const float* rw, bf16* H2, float* affl, float* affc,
                                              LAS unsigned char* lds, int bid, int G, int tid) {
    LAS unsigned short* WH = (LAS unsigned short*)lds;
    LAS unsigned short* WL = WH + 16 * 1032;
    __syncthreads();
    { f32x4 wv[8];
#pragma unroll
      for (int q = 0; q < 8; ++q) wv[q] = *(const f32x4*)(rw + (size_t)(q * NTHR + tid) * 4);
#pragma unroll
      for (int q = 0; q < 8; ++q) { const int i4 = q * NTHR + tid, col = i4 >> 2, e0 = (i4 & 3) * 4;
#pragma unroll
          for (int j = 0; j < 4; ++j) { const float w = wv[q][j]; const unsigned hi = pkbf(w, 0.f) & 0xffffu; const float lo = w - __uint_as_float(hi << 16);
              WH[(e0 + j) * 1032 + col] = (unsigned short)hi; WL[(e0 + j) * 1032 + col] = (unsigned short)(pkbf(lo, 0.f) & 0xffffu); } } }
    __syncthreads();
    const int wave = tid >> 6, lane = tid & 63, n16 = lane & 15, g = lane >> 4, gw = bid * NWAVES + wave, NGW = G * NWAVES;
    const int ngroups = nrows >> 4;
    LAS float* PA = (LAS float*)(lds + 2 * 16 * 1032 * 2 + wave * 8192);
#define RT_SRC(grp_) ((grp_) * 16 + n16 >= NLAT ? XC + (size_t)((grp_) * 16 + n16 - NLAT) * D : XL + (size_t)((grp_) * 16 + n16) * 2048)
    float ss_next = 0.f;
    if (gw < ngroups) { const bf16* s0 = RT_SRC(gw);
#pragma unroll 16
        for (int kk = 0; kk < 32; ++kk) { float a[8]; unpack8(*(const v4u*)(s0 + 32 * kk + 8 * g), a);
            ss_next += (a[0] * a[0] + a[1] * a[1]) + (a[2] * a[2] + a[3] * a[3]) + (a[4] * a[4] + a[5] * a[5]) + (a[6] * a[6] + a[7] * a[7]); } }
    for (int grp = gw; grp < ngroups; grp += NGW) {
        const int row = grp * 16 + n16; const bool isc = row >= NLAT; const bf16* src = RT_SRC(grp); const int gb = isc ? 32 : row >> 11;
        const bf16* srcn = (grp + NGW < ngroups) ? RT_SRC(grp + NGW) : src;
        const float* m = modl + (size_t)gb * MODW; bf16* hrow = H2 + (size_t)row * D;
#pragma unroll
        for (int i = 0; i < 4; ++i) { const int c = (i * 64 + lane) * 4; const f32x4 gg = *(const f32x4*)(nw + c), sh = *(const f32x4*)(m + 3 * 1024 + c), sc = *(const f32x4*)(m + 4 * 1024 + c);
            *(LAS f32x4*)(PA + c) = gg * (sc + 1.f); *(LAS f32x4*)(PA + 1024 + c) = sh; }
        float ss = ss_next + 0.f; ss_next = 0.f;
        ss = rows_sum(ss);
        const float rstd = rsqrtf(ss * (1.f / 1024.f) + 1e-6f);
        f32x4 acc = (f32x4){0.f, 0.f, 0.f, 0.f};
#pragma unroll 8
        for (int kk = 0; kk < 32; ++kk) { const int c0 = 32 * kk + 8 * g; float x[8], h[8], lo[8];
            unpack8(*(const v4u*)(src + c0), x);
            { float a[8]; unpack8(*(const v4u*)(srcn + c0), a); ss_next += (a[0] * a[0] + a[1] * a[1]) + (a[2] * a[2] + a[3] * a[3]) + (a[4] * a[4] + a[5] * a[5]) + (a[6] * a[6] + a[7] * a[7]); }
#pragma unroll
            for (int hf = 0; hf < 2; ++hf) { const f32x4 aa = *(const LAS f32x4*)(PA + c0 + 4 * hf), sh = *(const LAS f32x4*)(PA + 1024 + c0 + 4 * hf);
#pragma unroll
                for (int i = 0; i < 4; ++i) h[4 * hf + i] = (x[4 * hf + i] * rstd) * aa[i] + sh[i]; }
            const v4u hp = pack8(h); *(v4u*)(hrow + c0) = hp;
            { float hh[8]; unpack8(hp, hh);
#pragma unroll
              for (int i = 0; i < 8; ++i) lo[i] = h[i] - hh[i]; }
            const bf16x8 ah = __builtin_bit_cast(bf16x8, hp), al = __builtin_bit_cast(bf16x8, pack8(lo));
            const bf16x8 bh = *(const LAS bf16x8*)(WH + n16 * 1032 + c0), bl = *(const LAS bf16x8*)(WL + n16 * 1032 + c0);
            acc = __builtin_amdgcn_mfma_f32_16x16x32_bf16(ah, bh, acc, 0, 0, 0); acc = __builtin_amdgcn_mfma_f32_16x16x32_bf16(ah, bl, acc, 0, 0, 0); acc = __builtin_amdgcn_mfma_f32_16x16x32_bf16(al, bh, acc, 0, 0, 0); }
#pragma unroll
        for (int j = 0; j < 4; ++j) { float v = acc[j]; float mx = v;
            mx = fmaxf(mx, dppmov<0xB1>(mx)); mx = fmaxf(mx, dppmov<0x4E>(mx)); mx = fmaxf(mx, dppmov<0x141>(mx)); mx = fmaxf(mx, dppmov<0x140>(mx));
            const float ex = expf(v - mx); float sm = ex; sm += dppmov<0xB1>(sm); sm += dppmov<0x4E>(sm); sm += dppmov<0x141>(sm); sm += dppmov<0x140>(sm);
            const float aff = ex / sm; const int r = grp * 16 + 4 * g + j;
            if (r < NLAT) affl[((size_t)(r >> 11) * 16 + n16) * SEQ + (r & 2047)] = aff; else { const int rc = r - NLAT; affc[((size_t)(rc >> 8) * 16 + n16) * CTXL + (rc & 255)] = aff; } }
    }
#undef RT_SRC
}
template <int J>
__device__ __forceinline__ void topk_unit(const float* vals, int cap, int row0, int Rbase, int e, int* stok, float* sgate, short* inv, int lane) {
    unsigned vb[J];
#pragma unroll
    for (int j = 0; j < J; ++j) vb[j] = __float_as_uint(vals[j * 64 + lane]);
    unsigned T = 0u;
    for (int bit = 31; bit >= 0; --bit) { const unsigned cand = T | (1u << bit); int c = 0;
#pragma unroll
        for (int j = 0; j < J; ++j) c += (vb[j] >= cand) ? 1 : 0;
        c = wave_sum_i(c);
        if (c >= cap) T = cand; }
    int ngt = 0;
#pragma unroll
    for (int j = 0; j < J; ++j) ngt += (vb[j] > T) ? 1 : 0;
    ngt = wave_sum_i(ngt);
    const int need_eq = cap - ngt;
    const unsigned long long lt = (lane == 0) ? 0ull : (~0ull >> (64 - lane));
    int base = 0, eqseen = 0;
#pragma unroll
    for (int j = 0; j < J; ++j) {
        const bool gt = vb[j] > T, eq = vb[j] == T;
        const unsigned long long meq = __ballot(eq); const int eqrank = eqseen + __popcll(meq & lt);
        const bool sel = gt || (eq && eqrank < need_eq);
        const unsigned long long msel = __ballot(sel); const int slot = base + __popcll(msel & lt);
        const int row = row0 + j * 64 + lane;
        if (sel) { const int R = Rbase + slot; stok[R] = row; sgate[R] = __uint_as_float(vb[j]); inv[(size_t)row * 16 + e] = (short)slot; }
        else inv[(size_t)row * 16 + e] = (short)-1;
        base += __popcll(msel); eqseen += __popcll(meq);
    }
}
__device__ __forceinline__ void p_topk(const float* affl, const float* affc, int nunits, int rpe, int* stok, float* sgate, short* inv, int gw, int NGW, int lane) {
    for (int u = gw; u < nunits; u += NGW) {
        const bool isc = u >= 512; const int uu = u & 511, b = uu >> 4, e = uu & 15;
        if (!isc) topk_unit<32>(affl + (size_t)(b * 16 + e) * SEQ, SEQ >> 3, b * SEQ, e * rpe + b * 256, e, stok, sgate, inv, lane);
        else topk_unit<4>(affc + (size_t)(b * 16 + e) * CTXL, CTXL >> 3, NLAT + b * CTXL, e * rpe + 8192 + b * 32, e, stok, sgate, inv, lane);
    }
}
__device__ __forceinline__ void p_gather(const bf16* H2, const int* stok, int nslots, bf16* XIN, int gw, int NGW, int lane) {
    for (int R = gw; R < nslots; R += NGW) { const int row = stok[R]; const v4u* s = (const v4u*)(H2 + (size_t)row * D); v4u* d = (v4u*)(XIN + (size_t)R * D); d[lane] = s[lane]; d[64 + lane] = s[64 + lane]; }
}
template <int MODE>
__device__ __forceinline__ void p_combine(bf16* XL, bf16* XC, int nrows, const bf16* Y, const short* inv, int rpe, const float* modl, const float* modn, const float* nw, bf16* HN, int gw, int NGW, int lane) {
    v2u xn[2][4]; v4u in0[2], in1[2];
#define CMB_XP(r_) ((r_) >= NLAT ? XC + (size_t)((r_) - NLAT) * D : XL + (size_t)(r_) * 2048)
#define CMB_PRE(k_, r_) do { const int rr_ = (r_); if (rr_ < nrows) { const bf16* xp_ = CMB_XP(rr_); _Pragma("unroll") for (int j = 0; j < 4; ++j) xn[k_][j] = *(const v2u*)(xp_ + 4 * lane + 256 * j); \
        in0[k_] = *(const v4u*)(inv + (size_t)rr_ * 16); in1[k_] = *(const v4u*)(inv + (size_t)rr_ * 16 + 8); } } while (0)
    CMB_PRE(0, gw); CMB_PRE(1, gw + NGW);
    for (int row0 = gw; row0 < nrows; row0 += 2 * NGW) {
        f32x4 acc[2][4], x[2][4]; unsigned iw[2][8]; bool ok[2]; int offs[2];
#pragma unroll
        for (int k = 0; k < 2; ++k) { const int row = row0 + k * NGW; ok[k] = row < nrows; const bool isc = row >= NLAT; offs[k] = isc ? 8192 + ((row - NLAT) >> 8) * 32 : (row >> 11) * 256;
#pragma unroll
            for (int j = 0; j < 4; ++j) { acc[k][j] = (f32x4){0.f, 0.f, 0.f, 0.f}; x[k][j] = (f32x4){bflo(xn[k][j].x), bfhi(xn[k][j].x), bflo(xn[k][j].y), bfhi(xn[k][j].y)}; }
            iw[k][0] = in0[k].x; iw[k][1] = in0[k].y; iw[k][2] = in0[k].z; iw[k][3] = in0[k].w; iw[k][4] = in1[k].x; iw[k][5] = in1[k].y; iw[k][6] = in1[k].z; iw[k][7] = in1[k].w; }
        CMB_PRE(0, row0 + 2 * NGW); CMB_PRE(1, row0 + 3 * NGW);
#pragma unroll
        for (int e = 0; e < 16; ++e)
#pragma unroll
            for (int k = 0; k < 2; ++k) { const int s = __builtin_amdgcn_readfirstlane((int)(short)((e & 1) ? (iw[k][e >> 1] >> 16) : (iw[k][e >> 1] & 0xffffu)));
                if (ok[k] && s >= 0) { const bf16* yr = Y + ((size_t)e * rpe + offs[k] + s) * D + 4 * lane;
#pragma unroll
                    for (int j = 0; j < 4; ++j) { const v2u p = *(const v2u*)(yr + 256 * j); acc[k][j].x += bflo(p.x); acc[k][j].y += bfhi(p.x); acc[k][j].z += bflo(p.y); acc[k][j].w += bfhi(p.y); } } }
#pragma unroll
        for (int k = 0; k < 2; ++k) { const int row = row0 + k * NGW; if (!ok[k]) continue;
            const bool isc = row >= NLAT; bf16* xr = isc ? XC + (size_t)(row - NLAT) * D : XL + (size_t)row * 2048; const int gb = isc ? 32 : row >> 11;
            const float* m5 = modl + (size_t)gb * MODW + 5 * 1024;
#pragma unroll
            for (int j = 0; j < 4; ++j) x[k][j] = x[k][j] + *(const f32x4*)(m5 + 4 * lane + 256 * j) * acc[k][j];
            if (MODE == 0) {
                f32x4 xq[4];
#pragma unroll
                for (int j = 0; j < 4; ++j) { v2u w; w.x = pkbf(x[k][j].x, x[k][j].y); w.y = pkbf(x[k][j].z, x[k][j].w); *(v2u*)(xr + 4 * lane + 256 * j) = w; xq[j] = (f32x4){bflo(w.x), bfhi(w.x), bflo(w.y), bfhi(w.y)}; }
                const float rstd = row_rstd(xq);
                const float* mn = modn + (size_t)gb * MODW; f32x4 h[4]; modulate_row(xq, rstd, nw, mn, mn + 1024, lane, h); store_row_bf16(h, HN + (size_t)row * 2048, lane);
            } else {
                const float rstd = row_rstd(x[k]); float* orow = (float*)XL + (size_t)row * D;
#pragma unroll
                for (int j = 0; j < 4; ++j) *(f32x4*)(orow + 4 * lane + 256 * j) = x[k][j] * rstd * *(const f32x4*)(nw + 4 * lane + 256 * j);
            } }
    }
#undef CMB_PRE
#undef CMB_XP
}
__device__ __forceinline__ void p_shift(bf16* HN, const float* mu, bf16* XR, int xr_pitch, bf16* XK, bf16* XV, int gw, int NGW, int lane) {
    const int per = (NTOK + NGW - 1) / NGW, r0 = gw * per, r1 = (r0 + per < NTOK) ? r0 + per : NTOK;
    if (r0 >= r1) return;
    float mr[16], mk[16], mv[16];
#pragma unroll
    for (int qh = 0; qh < 2; ++qh)
#pragma unroll
        for (int hf = 0; hf < 2; ++hf) { const int c = qh * 512 + 8 * lane + 4 * hf; const f32x4 a = *(const f32x4*)(mu + c), k = *(const f32x4*)(mu + 2 * 1024 + c), v = *(const f32x4*)(mu + 3 * 1024 + c);
#pragma unroll
            for (int i = 0; i < 4; ++i) { mr[8 * qh + 4 * hf + i] = a[i]; mk[8 * qh + 4 * hf + i] = k[i]; mv[8 * qh + 4 * hf + i] = v[i]; } }
    struct RowSet { v4u q[2]; };
#define SH_LOAD(S_, r_) do { int rr_ = (r_); rr_ = rr_ < 0 ? 0 : (rr_ >= NTOK ? NTOK - 1 : rr_); S_.q[0] = *(const v4u*)(HN + (size_t)rr_ * 2048 + 8 * lane); S_.q[1] = *(const v4u*)(HN + (size_t)rr_ * 2048 + 512 + 8 * lane); } while (0)
#define SH_STEP(P_, C_, N_, L_, r_) do { const int row = (r_); if (row < r1) { SH_LOAD(L_, row + 2); \
        const bool isc = row >= NLAT; const int t = isc ? (row - NLAT) & 255 : row & 2047, len = isc ? CTXL : SEQ; const bool hp = t > 0, hn = t < len - 1; \
        _Pragma("unroll") for (int qh = 0; qh < 2; ++qh) { float a[8], c[8], h[8]; unpack8(P_.q[qh], a); unpack8(N_.q[qh], c); unpack8(C_.q[qh], h); \
            _Pragma("unroll") for (int i = 0; i < 8; ++i) a[i] = 0.5f * ((hp ? a[i] : 0.f) + (hn ? c[i] : 0.f)); \
            *(v4u*)(HN + (size_t)row * 2048 + 1024 + qh * 512 + 8 * lane) = pack8(a); \
            _Pragma("unroll") for (int i = 0; i < 8; ++i) { a[i] -= h[i]; c[i] = h[i] + mk[8 * qh + i] * a[i]; } \
            *(v4u*)(XK + (size_t)row * D + qh * 512 + 8 * lane) = pack8(c); \
            _Pragma("unroll") for (int i = 0; i < 8; ++i) c[i] = h[i] + mv[8 * qh + i] * a[i]; \
            *(v4u*)(XV + (size_t)row * D + qh * 512 + 8 * lane) = pack8(c); \
            if (!isc) { \
                _Pragma("unroll") for (int i = 0; i < 8; ++i) c[i] = h[i] + mr[8 * qh + i] * a[i]; \
                *(v4u*)(XR + (size_t)row * xr_pitch + qh * 512 + 8 * lane) = pack8(c); } } } } while (0)
    RowSet sa, sb, sc, sd; SH_LOAD(sa, r0 - 1); SH_LOAD(sb, r0); SH_LOAD(sc, r0 + 1);
#pragma unroll 1
    for (int r = r0; r < r1; r += 4) { SH_STEP(sa, sb, sc, sd, r); SH_STEP(sb, sc, sd, sa, r + 1); SH_STEP(sc, sd, sa, sb, r + 2); SH_STEP(sd, sa, sb, sc, r + 3); }
#undef SH_STEP
#undef SH_LOAD
}
__device__ __forceinline__ bf16x8 mk8(v2u a, v2u b) { v4u w; w.x = a.x; w.y = a.y; w.z = b.x; w.w = b.y; return __builtin_bit_cast(bf16x8, w); }
__device__ __forceinline__ v2u pk4(f32x4 v) { v2u w; w.x = pkbf(v.x, v.y); w.y = pkbf(v.z, v.w); return w; }
#define MFMA16(a, b, c) __builtin_amdgcn_mfma_f32_16x16x32_bf16((a), (b), (c), 0, 0, 0)
__device__ __forceinline__ void p_wkv(const bf16* R, const bf16* K, const bf16* V, const bf16* L, const float* w0, const float* w2, const float* a0, const float* a2,
                                      const float* kkw, const float* kaw, const float* rkw, bf16* Y, size_t yds, float* COEF, LAS unsigned char* lds, int bid, int G, int tid, int variant = 0) {
    constexpr int CHB = 11776, O_BH = 0, O_KH = 2304, O_AT = 4608, O_RT = 6912, O_V = 9216, O_WC = 11520, O_NS = 8 * CHB, O_CST = O_NS + 4096, O_W2 = O_CST + 1280, O_A2 = O_W2 + 8192;
#ifdef PROBE_ROLE_PARITY
    const int wave = tid >> 6, lane = tid & 63, role = wave & 1, q = wave >> 1;
#else
    const int wave = tid >> 6, lane = tid & 63, role = wave >> 2, q = wave & 3;
#endif
    LAS float* CST = (LAS float*)(lds + O_CST);
    LAS float* NS = (LAS float*)(lds + O_NS + q * 1024);
    const f32x4 zero4 = (f32x4){0.f, 0.f, 0.f, 0.f}; const v2u zero2 = (v2u){0u, 0u};
    for (int u = bid; u < 256; u += G) {
        const int h = u & 15, dir = (u >> 4) & 1, b = (u >> 5) * 4 + q;
        __syncthreads();
        if (tid < 64) { CST[tid] = w0[dir * D + h * 64 + tid]; CST[64 + tid] = a0[dir * D + h * 64 + tid]; CST[128 + tid] = kkw[h * 64 + tid]; CST[192 + tid] = kaw[h * 64 + tid]; CST[256 + tid] = rkw[h * 64 + tid]; }
        for (int i = tid; i < 4096; i += NTHR) { const int c = i & 63, j = i >> 6; const size_t o = ((size_t)dir * 64 + j) * D + h * 64 + c;
            const int pj = ((((j >> 3) ^ (c & 7)) << 3) | (j & 7));
            ((LAS unsigned short*)(lds + O_W2))[c * 64 + pj] = (unsigned short)(pkbf(w2[o], 0.f) & 0xffffu); ((LAS unsigned short*)(lds + O_A2))[c * 64 + pj] = (unsigned short)(pkbf(a2[o], 0.f) & 0xffffu); }
        __syncthreads();
        if (role == 1) {
            v2u n_k[4], n_r[4]; v4u n_v0, n_v1; bf16x8 n_lw0, n_lw1, n_la0, n_la1;
#define WKV_ROW(ckx_, n16_) (((ckx_) < 16) ? (size_t)NLAT + b * CTXL + (dir == 0 ? (ckx_) * 16 + (n16_) : 255 - ((ckx_) * 16 + (n16_))) : (size_t)b * SEQ + (dir == 0 ? (ckx_) * 16 + (n16_) - 256 : 2047 - ((ckx_) * 16 + (n16_) - 256)))
#define WKV_LOAD(ckx_, n16_, g_) do { const size_t row_ = WKV_ROW(ckx_, n16_); const bool ic_ = (ckx_) < 16; \
                _Pragma("unroll") for (int mt = 0; mt < 4; ++mt) { n_k[mt] = *(const v2u*)(K + row_ * D + h * 64 + 16 * mt + 4 * (g_)); n_r[mt] = ic_ ? zero2 : *(const v2u*)(R + (ic_ ? 0 : row_) * D + h * 64 + 16 * mt + 4 * (g_)); } \
                n_v0 = *(const v4u*)(V + row_ * D + h * 64 + 8 * (g_)); n_v1 = *(const v4u*)(V + row_ * D + h * 64 + 32 + 8 * (g_)); \
                n_lw0 = *(const bf16x8*)(L + row_ * 512 + dir * 64 + 8 * (g_)); n_lw1 = *(const bf16x8*)(L + row_ * 512 + dir * 64 + 32 + 8 * (g_)); \
                n_la0 = *(const bf16x8*)(L + row_ * 512 + 128 + dir * 64 + 8 * (g_)); n_la1 = *(const bf16x8*)(L + row_ * 512 + 128 + dir * 64 + 32 + 8 * (g_)); } while (0)
            WKV_LOAD(0, lane & 15, lane >> 4);
            __builtin_amdgcn_s_setprio(2);
            float pend_bon = 0.f; long pend_idx = -1;
#pragma unroll 1
            for (int ck = -1; ck < 144; ++ck) {
                int ln_ = lane; asm volatile("" : "+v"(ln_));
                const int n16 = ln_ & 15, g = ln_ >> 4;
                const int ckn = ck + 1;
                if (pend_idx >= 0) { COEF[pend_idx] = pend_bon; pend_idx = -1; }
                if (ckn < 144 && variant != 1) {
                    LAS unsigned char* cb = lds + (q * 2 + (ckn & 1)) * CHB;
                    const bool iscn = ckn < 16;
                    const size_t row = WKV_ROW(ckn, n16);
                    v2u kraw[4], rraw[4];
#pragma unroll
                    for (int mt = 0; mt < 4; ++mt) { kraw[mt] = n_k[mt]; rraw[mt] = n_r[mt]; }
                    const v4u vr0 = n_v0, vr1 = n_v1; const bf16x8 lwf0 = n_lw0, lwf1 = n_lw1, laf0 = n_la0, laf1 = n_la1;
                    if (ckn + 1 < 144) WKV_LOAD(ckn + 1, n16, g);
#ifdef PROBE_PREP2
                    for (int rr_ = 0; rr_ < 2; ++rr_)
#endif
                    {
                    if (variant != 3) { *(LAS v4u*)(cb + O_V + n16 * 144 + g * 16) = vr0; *(LAS v4u*)(cb + O_V + n16 * 144 + 64 + g * 16) = vr1; }
                    asm volatile("" ::: "memory");
                    float Lc[16], ic[16], kkr[16]; float ss = 0.f;
#pragma unroll
                    for (int mt = 0; mt < 4; ++mt) {
                        const int sw0 = (g ^ (n16 & 7)) * 16, sw1 = ((4 + g) ^ (n16 & 7)) * 16;
                        const LAS unsigned char* wp = lds + O_W2 + (16 * mt + n16) * 128; const LAS unsigned char* ap = lds + O_A2 + (16 * mt + n16) * 128;
                        f32x4 wacc = zero4, aacc = zero4;
                        if (variant != 5) { wacc = MFMA16(*(const LAS bf16x8*)(wp + sw0), lwf0, zero4); wacc = MFMA16(*(const LAS bf16x8*)(wp + sw1), lwf1, wacc);
                        aacc = MFMA16(*(const LAS bf16x8*)(ap + sw0), laf0, zero4); aacc = MFMA16(*(const LAS bf16x8*)(ap + sw1), laf1, aacc); }
                        const f32x4 cw0 = *(const LAS f32x4*)(CST + 16 * mt + 4 * g), ca0 = *(const LAS f32x4*)(CST + 64 + 16 * mt + 4 * g), ckk = *(const LAS f32x4*)(CST + 128 + 16 * mt + 4 * g);
                        const float kf[4] = {bflo(kraw[mt].x), bfhi(kraw[mt].x), bflo(kraw[mt].y), bfhi(kraw[mt].y)};
#pragma unroll
                        for (int j = 0; j < 4; ++j) { const int e = mt * 4 + j;
                            Lc[e] = -0.8750387749145276f * sigmoid_fast(wacc[j] + cw0[j]);
                            ic[e] = sigmoid_fast(aacc[j] + ca0[j]); kkr[e] = kf[j] * ckk[j]; ss += kkr[e] * kkr[e]; }
                    }
                    ss = rows_sum(ss);
                    const float inv = rsqrtf(fmaxf(ss, 1e-24f));
#pragma unroll
                    for (int e = 0; e < 16; ++e) { float x = Lc[e]; x += dppz<0x111>(x); x += dppz<0x112>(x); x += dppz<0x114>(x); x += dppz<0x118>(x); Lc[e] = x; }
                    float bon = 0.f;
#pragma unroll
                    for (int x2 = 0; x2 < (variant == 4 ? 0 : 2); ++x2) {
                        float at8[8], rt8[8], bh8[8], kh8[8];
#pragma unroll
                        for (int mm = 0; mm < 2; ++mm) { const int mt = 2 * x2 + mm; const f32x4 cka = *(const LAS f32x4*)(CST + 192 + 16 * mt + 4 * g), crk = *(const LAS f32x4*)(CST + 256 + 16 * mt + 4 * g);
                            const float kf[4] = {bflo(kraw[mt].x), bfhi(kraw[mt].x), bflo(kraw[mt].y), bfhi(kraw[mt].y)}, rf[4] = {bflo(rraw[mt].x), bfhi(rraw[mt].x), bflo(rraw[mt].y), bfhi(rraw[mt].y)};
#pragma unroll
                            for (int j = 0; j < 4; ++j) { const int e = mt * 4 + j, o = mm * 4 + j;
                                float Wt = (variant == 6) ? Lc[e] : __builtin_amdgcn_exp2f(Lc[e]), iW = (variant == 6) ? -Lc[e] : __builtin_amdgcn_exp2f(-Lc[e]); const float Wm = (variant == 7) ? Wt : dpp_old<0x111>(1.f, Wt);
                                const float kk = kkr[e] * inv, kd = kf[j] * (1.f + (ic[e] - 1.f) * cka[j]), bb = kk * ic[e];
                                at8[o] = -kk * Wm; rt8[o] = rf[j] * Wt; bh8[o] = bb * iW; kh8[o] = kd * iW; bon += rf[j] * kd * crk[j];
                                } }
                        const int off = n16 * 144 + (x2 * 32 + g * 8) * 2;
                        if (variant != 8) { *(LAS v4u*)(cb + O_AT + off) = pack8(at8); *(LAS v4u*)(cb + O_RT + off) = pack8(rt8); *(LAS v4u*)(cb + O_BH + off) = pack8(bh8); *(LAS v4u*)(cb + O_KH + off) = pack8(kh8); }
                        else { *(LAS float*)(cb + O_AT + off) = at8[0] + at8[1] + at8[2] + at8[3] + at8[4] + at8[5] + at8[6] + at8[7] + rt8[0] + rt8[1] + rt8[2] + rt8[3] + rt8[4] + rt8[5] + rt8[6] + rt8[7] + bh8[0] + kh8[0]; }
                        asm volatile("" ::: "memory");
                    }
                    if (n16 == 15) {
#pragma unroll
                        for (int mt = 0; mt < 4; ++mt) *(LAS f32x4*)(cb + O_WC + (16 * mt + 4 * g) * 4) = (f32x4){__builtin_amdgcn_exp2f(Lc[4 * mt]), __builtin_amdgcn_exp2f(Lc[4 * mt + 1]), __builtin_amdgcn_exp2f(Lc[4 * mt + 2]), __builtin_amdgcn_exp2f(Lc[4 * mt + 3])}; }
                    if (!iscn) { bon = rows_sum(bon); if (g == 0) { pend_bon = bon; pend_idx = (long)(((size_t)dir * NLAT + row) * 16 + h); } }
                    }
                }
                asm volatile("s_waitcnt lgkmcnt(0)" ::: "memory"); __builtin_amdgcn_s_barrier(); asm volatile("" ::: "memory");
            }
            if (pend_idx >= 0) COEF[pend_idx] = pend_bon;
            __builtin_amdgcn_s_setprio(0);
#undef WKV_LOAD
#undef WKV_ROW
        } else {
            f32x4 st[4][4];
#pragma unroll
            for (int kt = 0; kt < 4; ++kt)
#pragma unroll
                for (int vt = 0; vt < 4; ++vt) st[kt][vt] = zero4;
            asm volatile("s_waitcnt lgkmcnt(0)" ::: "memory"); __builtin_amdgcn_s_barrier(); asm volatile("" ::: "memory");
#pragma unroll 1
            for (int ck = 0; ck < 144; ++ck) {
                int ln_ = lane; asm volatile("" : "+v"(ln_));
                const int n16 = ln_ & 15, g = ln_ >> 4;
                if (variant < 2) {
                const LAS unsigned char* cb = lds + (q * 2 + (ck & 1)) * CHB;
                bf16x8 bhf[2], khf[2], atf[2], rtf[2];
#pragma unroll
                for (int kp = 0; kp < 2; ++kp) { const int off = n16 * 144 + (kp * 32 + g * 8) * 2;
                    bhf[kp] = *(const LAS bf16x8*)(cb + O_BH + off); khf[kp] = *(const LAS bf16x8*)(cb + O_KH + off); atf[kp] = *(const LAS bf16x8*)(cb + O_AT + off); rtf[kp] = *(const LAS bf16x8*)(cb + O_RT + off); }
                f32x4 Nm = MFMA16(bhf[0], atf[0], zero4); Nm = MFMA16(bhf[1], atf[1], Nm);
                f32x4 Nt = MFMA16(atf[0], bhf[0], zero4); Nt = MFMA16(atf[1], bhf[1], Nt);
                f32x4 Aak = MFMA16(khf[0], atf[0], zero4); Aak = MFMA16(khf[1], atf[1], Aak);
                f32x4 Br = MFMA16(bhf[0], rtf[0], zero4); Br = MFMA16(bhf[1], rtf[1], Br);
                f32x4 Kr = MFMA16(khf[0], rtf[0], zero4); Kr = MFMA16(khf[1], rtf[1], Kr);
                f32x4 Pm, Pt;
#pragma unroll
                for (int j = 0; j < 4; ++j) { const int i = 4 * g + j; const bool lt = i < n16, le = i <= n16, gt_ = i > n16; const float dg = (i == n16) ? 1.f : 0.f;
                    Nm[j] = lt ? Nm[j] : 0.f; Nt[j] = gt_ ? Nt[j] : 0.f; Aak[j] = lt ? Aak[j] : 0.f; Br[j] = le ? Br[j] : 0.f; Kr[j] = le ? Kr[j] : 0.f; Pm[j] = Nm[j] + dg; Pt[j] = Nt[j] + dg; }
#define XY(xt_, y_, c_) MFMA16(mk8(pk4(xt_), zero2), mk8(pk4(y_), zero2), (c_))
                f32x4 M2 = XY(Nt, Nm, zero4), M2t = XY(Nm, Nt, zero4);
                { const f32x4 Pn = XY(Pt, M2, Pm), Ptn = XY(M2, Pt, Pt); Pm = Pn; Pt = Ptn; }
                const f32x4 M4 = XY(M2t, M2, zero4), M4t = XY(M2, M2t, zero4);
                { const f32x4 Pn = XY(Pt, M4, Pm), Ptn = XY(M4, Pt, Pt); Pm = Pn; Pt = Ptn; }
                const f32x4 M8 = XY(M4t, M4, zero4);
                const f32x4 tsel = XY(Pt, M8, Pm);
#undef XY
                const bf16x8 tfr = mk8(pk4(tsel), zero2), aakfr = mk8(pk4(Aak), zero2), bkfr = mk8(pk4(Br), pk4(Kr));
                const bool isc = ck < 16;
                bf16* yrow; { const int sl = ck * 16 + n16 - 256; const size_t row = (size_t)b * SEQ + (dir == 0 ? sl : 2047 - sl); yrow = Y + (size_t)dir * yds + (isc ? 0 : row) * D + h * 64 + 4 * g; }
#pragma unroll
                for (int vt = 0; vt < 4; ++vt) {
                    const LAS unsigned char* trb = cb + (4 * g + (n16 >> 2)) * 144 + (n16 & 3) * 8;
                    const v2u vm = __builtin_bit_cast(v2u, __builtin_amdgcn_ds_read_tr16_b64_v4i16((LAS short4v*)(trb + O_V + vt * 32)));
                    const bf16x8 sf0 = mk8(pk4(st[0][vt]), pk4(st[1][vt])), sf1 = mk8(pk4(st[2][vt]), pk4(st[3][vt]));
                    f32x4 gt = MFMA16(atf[0], sf0, zero4); gt = MFMA16(atf[1], sf1, gt); gt = MFMA16(aakfr, mk8(vm, zero2), gt);
                    const f32x4 ut = MFMA16(tfr, mk8(pk4(gt), zero2), zero4);
                    const bf16x8 uv = mk8(pk4(ut), vm);
                    if (!isc) {
                        f32x4 yv = MFMA16(sf0, rtf[0], zero4); yv = MFMA16(sf1, rtf[1], yv); yv = MFMA16(uv, bkfr, yv);
                        *(v2u*)(yrow + 16 * vt) = pk4(yv);
                    }
#pragma unroll
                    for (int kt = 0; kt < 4; ++kt) {
                        const v2u bt = __builtin_bit_cast(v2u, __builtin_amdgcn_ds_read_tr16_b64_v4i16((LAS short4v*)(trb + O_BH + (kt >> 1) * 64 + (kt & 1) * 8 + (n16 & 3) * 8))), kt2 = __builtin_bit_cast(v2u, __builtin_amdgcn_ds_read_tr16_b64_v4i16((LAS short4v*)(trb + O_KH + (kt >> 1) * 64 + (kt & 1) * 8 + (n16 & 3) * 8)));
                        st[kt][vt] = MFMA16(mk8(bt, kt2), uv, st[kt][vt]); }
                    asm volatile("" ::: "memory");
                }
#pragma unroll
                for (int kt = 0; kt < 4; ++kt) { const f32x4 wc = *(const LAS f32x4*)(cb + O_WC + (16 * kt + 4 * g) * 4);
#pragma unroll
                    for (int vt = 0; vt < 4; ++vt) st[kt][vt] *= wc; }
                }
                asm volatile("s_waitcnt lgkmcnt(0)" ::: "memory"); __builtin_amdgcn_s_barrier(); asm volatile("" ::: "memory");
            }
        }
    }
}
__device__ __forceinline__ void p_finish(const bf16* Y, size_t yds, const float* COEF, const bf16* V, const bf16* Gt, int gpitch, const float* gng, const float* gnb, bf16* A2, int gw, int NGW, int lane) {
    const int c0 = lane * 16, h = lane >> 2;
    v4u n_y[4], n_v[2], n_g[2]; float n_b0 = 0.f, n_b1 = 0.f;
#define FIN_LOAD(r_) do { const size_t r = (size_t)(r_); n_y[0] = *(const v4u*)(Y + r * D + c0); n_y[1] = *(const v4u*)(Y + r * D + c0 + 8); n_y[2] = *(const v4u*)(Y + yds + r * D + c0); n_y[3] = *(const v4u*)(Y + yds + r * D + c0 + 8); \
        n_v[0] = *(const v4u*)(V + r * D + c0); n_v[1] = *(const v4u*)(V + r * D + c0 + 8); n_g[0] = *(const v4u*)(Gt + r * gpitch + c0); n_g[1] = *(const v4u*)(Gt + r * gpitch + c0 + 8); \
        n_b0 = COEF[r * 16 + h]; n_b1 = COEF[((size_t)NLAT + r) * 16 + h]; } while (0)
    if (gw < NLAT) FIN_LOAD(gw);
    for (int row = gw; row < NLAT; row += NGW) {
        float ys[16], t8[8]; v4u c_v[2], c_g[2];
        unpack8(n_y[0], t8);
#pragma unroll
        for (int i = 0; i < 8; ++i) ys[i] = t8[i];
        unpack8(n_y[1], t8);
#pragma unroll
        for (int i = 0; i < 8; ++i) ys[8 + i] = t8[i];
        unpack8(n_y[2], t8);
#pragma unroll
        for (int i = 0; i < 8; ++i) ys[i] += t8[i];
        unpack8(n_y[3], t8);
#pragma unroll
        for (int i = 0; i < 8; ++i) ys[8 + i] += t8[i];
        c_v[0] = n_v[0]; c_v[1] = n_v[1]; c_g[0] = n_g[0]; c_g[1] = n_g[1]; const float bon = n_b0 + n_b1;
        if (row + NGW < NLAT) FIN_LOAD(row + NGW);
        float s = 0.f;
#pragma unroll
        for (int i = 0; i < 16; ++i) s += ys[i];
        s = sum4(s); const float mu = s * (1.f / 64.f);
        float qv = 0.f;
#pragma unroll
        for (int i = 0; i < 16; ++i) { const float d = ys[i] - mu; qv += d * d; }
        qv = sum4(qv); const float rs = rsqrtf(qv * (1.f / 64.f) + 64e-5f);
#pragma unroll
        for (int hf = 0; hf < 2; ++hf) { float vf[8], gf[8], o[8]; unpack8(c_v[hf], vf); unpack8(c_g[hf], gf);
#pragma unroll
            for (int i = 0; i < 8; ++i) { const int c = c0 + 8 * hf + i; o[i] = ((ys[8 * hf + i] - mu) * rs * gng[c] + gnb[c] + bon * vf[i]) * gf[i]; }
            *(v4u*)(A2 + (size_t)row * D + c0 + 8 * hf) = pack8(o); }
    }
#undef FIN_LOAD
}
#ifndef PROBE_DUP
#define PROBE_DUP -1
#endif
#ifndef PROBE_N
#define PROBE_N 2
#endif
#define REP(k) ((PROBE_DUP == (k)) ? PROBE_N : 1)
#ifndef MK_PER_PHASE
#define MK_PER_PHASE 0
#endif
struct ConvJob { int in_idx, src_off, K, N, nmat, sms, dst_mib, dst_off, dms, pitch, koff, Kpad, mode, row_off, mu_idx, smode; };
#define LOR(idx, d, rowb, mi) {idx, (d) * 65536, 1024, 64, 1, 0, 28, 0, 0, 2048, 0, 1024, 0, (rowb) + (d) * 64, mi, 1}, {idx, (d) * 65536, 1024, 64, 1, 0, 28, 0, 0, 2048, 1024, 1024, 0, (rowb) + (d) * 64, mi, 2}
#define EXPERT(l) {9, (l) * 16777216, 1024, 1024, 16, 1048576, 46 + (l) * 96, 0, 2097152, 1024, 0, 1024, 1, 0, 0, 0}, {10, (l) * 16777216, 1024, 1024, 16, 1048576, 46 + (l) * 96, 0, 2097152, 1024, 0, 1024, 1, 4, 0, 0}, \
                  {11, (l) * 16777216, 1024, 1024, 16, 1048576, 46 + (l) * 96 + 64, 0, 1048576, 1024, 0, 1024, 0, 0, 0, 0}
__constant__ ConvJob CONV_JOBS[] = {
    {12, 0, 1024, QW, 1, 0, 22, 0, 0, 1024, 0, 1024, 0, 0, 0, 0},
    {13, 0, 1024, 1024, 1, 0, 26, 0, 0, 1024, 0, 1024, 0, 0, 0, 0},
    {37, 0, 1024, 1024, 1, 0, 43, 0, 0, 1024, 0, 1024, 0, 0, 0, 0},
    {31, 0, 160, 1024, 1, 0, 42, 0, 0, 256, 0, 256, 0, 0, 0, 0},
    {23, 0, 1024, 1024, 1, 0, 40, 0, 0, 1024, 0, 1024, 0, 0, 0, 0},
    {23, 1 * 1048576, 1024, 1024, 1, 0, 28, 0, 0, 1024, 0, 1024, 0, 0, 0, 0}, {23, 2 * 1048576, 1024, 1024, 1, 0, 30, 0, 0, 1024, 0, 1024, 0, 0, 0, 0},
    LOR(25, 0, 2048, 1), LOR(25, 1, 2048, 1), LOR(28, 0, 2176, 4), LOR(28, 1, 2176, 4),
    {30, 0, 1024, 160, 1, 0, 28, 0, 0, 2048, 0, 1024, 0, 2304, 5, 1}, {30, 0, 1024, 160, 1, 0, 28, 0, 0, 2048, 1024, 1024, 0, 2304, 5, 2},
    EXPERT(0), EXPERT(1)
};
constexpr int NJOBS = sizeof(CONV_JOBS) / sizeof(ConvJob);
constexpr int NPHASE = 24;
struct Args { const float* in[39]; float* out; unsigned char* ws; int ph_lo, ph_hi; };
__device__ __forceinline__ const float* ldp(const LAS unsigned long long* tab, int k) {
    const unsigned long long v = *(const volatile LAS unsigned long long*)(tab + k);
    const unsigned lo = __builtin_amdgcn_readfirstlane((unsigned)v), hi = __builtin_amdgcn_readfirstlane((unsigned)(v >> 32));
    return (const float*)(const GAS float*)(((unsigned long long)hi << 32) | lo);
}
__device__ __forceinline__ bool in_window(const LAS unsigned long long* tab, int k) {
    unsigned a = (unsigned)(size_t)(tab + 41); asm volatile("" : "+v"(a));
    const unsigned long long v = *(const volatile LAS unsigned long long*)a;
    const int lo = (int)__builtin_amdgcn_readfirstlane((unsigned)v), hi = (int)__builtin_amdgcn_readfirstlane((unsigned)(v >> 32));
    return lo <= k && k < hi;
}
__global__ void __launch_bounds__(NTHR, 2) mk_fwd(Args args) {
    extern __shared__ __attribute__((aligned(16))) unsigned char lds_raw[];
    LAS unsigned char* lds = (LAS unsigned char*)lds_raw;
    const int tid0 = threadIdx.x; const int wave_s = __builtin_amdgcn_readfirstlane(tid0 >> 6);
    const int G = gridDim.x, bid = blockIdx.x, NGW = G * NWAVES;
    volatile LAS unsigned* MISC = (volatile LAS unsigned*)(lds + MISC_OFF);
    LAS unsigned long long* tabw = (LAS unsigned long long*)(lds + TAB_OFF);
    const LAS unsigned long long* tab = tabw;
    for (int u = tid0; u < (LDS_BYTES - CTRL_BASE) / 4; u += NTHR) ((LAS unsigned*)(lds + CTRL_BASE))[u] = 0u;
    __syncthreads();
    if (tid0 == 0) {
#pragma unroll
        for (int i = 0; i < 39; ++i) tabw[i] = (unsigned long long)args.in[i];
        tabw[39] = (unsigned long long)args.ws; tabw[40] = (unsigned long long)args.out; tabw[41] = (unsigned long long)(unsigned)args.ph_lo | ((unsigned long long)(unsigned)args.ph_hi << 32);
    }
    __syncthreads();
    (void)xcd_barrier_post((unsigned*)(args.ws + WS_CTL) + CW_BAR, MISC + 8);
#define IN(k) in_window(tab, (k))
#define SEAM(k) do { if (IN(k) && IN((k) + 1)) { XcdBarrier b_; b_.bar = (unsigned*)ldp(tab, 39) + CW_BAR; b_.x = xb_xcc_id(); b_.st = MISC + 8; xcd_barrier(b_); } } while (0)
#define INP(k) ldp(tab, (k))
#define PH const int tid = opaque_tid(wave_s), lane = tid & 63, wave = __builtin_amdgcn_readfirstlane(tid >> 6), gw = bid * NWAVES + wave; (void)lane; (void)gw; \
           unsigned char* const ws = (unsigned char*)ldp(tab, 39); bf16* const xl = (bf16*)ldp(tab, 40); (void)ws; (void)xl
#define MODACC ((float*)(ws + WS_MOD))
#define ROPE ((float*)(ws + WS_ROPE))
#define AFFL ((float*)(ws + WS_AFFL))
#define AFFC ((float*)(ws + WS_AFFC))
#define STOK ((int*)(ws + (layer == 0 ? WS_STOK : WS_STOK1)))
#define SGATE ((float*)(ws + WS_SGATE))
#define INVT ((short*)(ws + WS_INV))
#define COEF ((float*)(ws + WS_COEF))
#define WIN_T ((bf16*)(ws + WS_WIN))
#define WOUT_T ((bf16*)(ws + WS_WOUT))
#define WBIG_T ((bf16*)(ws + WS_WBIG))
#define WR_T ((bf16*)(ws + WS_WR))
#define G2_T ((bf16*)(ws + WS_G2))
#define WO_T ((bf16*)(ws + WS_WO))
#define XCP ((bf16*)(ws + WS_XC))
#define HB ((bf16*)(ws + WS_H))
#define R1P ((bf16*)(ws + WS_R1))
#define R2P ((bf16*)(ws + WS_R2))
#define LORAP ((bf16*)(ws + WS_LORA))
#define A2P (R1P + (size_t)NTOK * D)

    if (IN(0)) { PH;
        for (int rep = 0; rep < REP(40); ++rep) p_mods(INP(1), INP(3), INP(4), INP(5), MODACC, lds, bid, G, tid);
        { float* rope = ROPE; for (int i = bid * NTHR + tid; i < 96 * 16; i += G * NTHR) { const int pos = i >> 4, f = i & 15, pp = pos < 32 ? pos : pos - 32; const float ivf = powf(10000.f, -(float)(2 * f) / 32.f), ang = (float)pp * ivf; rope[2 * i] = cosf(ang); rope[2 * i + 1] = sinf(ang); } }
        __syncthreads();
        LAS float* scr = (LAS float*)(lds + wave * 16640);
#ifdef PROBE_CONV_VARIANT
        { int gstart = 0;
        for (int jx = 0; jx < NJOBS; ++jx) {
            const ConvJob J = CONV_JOBS[jx]; int gcount = 0;
            conv_items(INP(J.in_idx) + J.src_off, J.K, J.N, J.nmat, (size_t)J.sms, (bf16*)(ws + (size_t)J.dst_mib * MiB) + J.dst_off, (size_t)J.dms, J.pitch, J.koff, J.Kpad, J.mode, J.row_off, INP(22) + J.mu_idx * 1024, J.smode, scr, gw, NGW, lane, gstart, gcount, PROBE_CONV_VARIANT);
            gstart += gcount;
        } }
#endif
        for (int rep = 0; rep < REP(0); ++rep) {
        { int gstart = 0;
          for (int jx = 0; jx < NJOBS; ++jx) { const ConvJob J = CONV_JOBS[jx]; if ((J.K & 255) || (J.N & 255)) continue; int gcount = 0;
              conv_block_items(INP(J.in_idx) + J.src_off, J.K, J.N, J.nmat, (size_t)J.sms, (bf16*)(ws + (size_t)J.dst_mib * MiB) + J.dst_off, (size_t)J.dms, J.pitch, J.koff, J.mode, J.row_off, INP(22) + J.mu_idx * 1024, J.smode, lds, bid, G, tid, gstart, gcount);
              gstart += gcount; } }
        { int gstart = 0;
          for (int jx = 0; jx < NJOBS; ++jx) { const ConvJob J = CONV_JOBS[jx]; if (!((J.K & 255) || (J.N & 255))) continue; int gcount = 0;
              conv_items(INP(J.in_idx) + J.src_off, J.K, J.N, J.nmat, (size_t)J.sms, (bf16*)(ws + (size_t)J.dst_mib * MiB) + J.dst_off, (size_t)J.dms, J.pitch, J.koff, J.Kpad, J.mode, J.row_off, INP(22) + J.mu_idx * 1024, J.smode, scr, gw, NGW, lane, gstart, gcount);
              gstart += gcount; } } }
        { v4u* z = (v4u*)(WBIG_T + (size_t)2464 * 2048); const int n16 = 96 * 2048 * 2 / 16; for (int i = bid * NTHR + tid; i < n16; i += G * NTHR) z[i] = (v4u){0u, 0u, 0u, 0u}; }
    }
    SEAM(0);
    for (int layer = 0; layer < 2; ++layer) {
        if (layer == 0) {
            if (IN(1)) { PH; for (int rep = 0; rep < REP(1); ++rep) p_norm0(INP(0), INP(2), INP(6), MODACC, HB, gw, NGW, lane); }
            SEAM(1);
#ifdef PROBE_BARRIERS
            if (IN(1)) for (int rb_ = 0; rb_ < PROBE_BARRIERS; ++rb_) { XcdBarrier b_; b_.bar = (unsigned*)ldp(tab, 39) + CW_BAR; b_.x = xb_xcc_id(); b_.st = MISC + 8; xcd_barrier(b_); }
#endif
            if (IN(2)) { PH; pg8::Gemm g{HB, WIN_T, NTOK, QW, 1024, 1024, 1 << 30, 0, nullptr}; pg8::StaticOrder S; S.init(NTOK, QW, G, bid); pg8::EpiBf16 E{R1P, QW};
                for (int rep = 0; rep < REP(2); ++rep) pg8::gemm_phase<pg8::EpiBf16, pg8::StaticOrder, true, true>(lds, g, S, E, wave_s); }
            SEAM(2);
            if (IN(3)) { PH; for (int rep = 0; rep < REP(30); ++rep) { p_attn(R1P, ROPE, INP(14), HB, lds, bid, G, tid); __syncthreads(); }
                #ifdef PROBE_LRU_VARIANT
                p_lru(R1P, INP(15), INP(16), INP(17), INP(18), INP(19), INP(20), INP(21), (float*)R2P, HB, lds, bid, G, tid, PROBE_LRU_VARIANT); __syncthreads();
#endif
                for (int rep = 0; rep < REP(31); ++rep) { p_lru(R1P, INP(15), INP(16), INP(17), INP(18), INP(19), INP(20), INP(21), (float*)R2P, HB, lds, bid, G, tid); __syncthreads(); } }
            SEAM(3);
        } else {
            if (IN(11)) { PH; for (int rep = 0; rep < REP(11); ++rep) p_shift(R2P, INP(22), xl + 1024, 2048, HB, R1P, gw, NGW, lane); }
            do { if (IN(11) && IN(23)) { XcdBarrier b_; b_.bar = (unsigned*)ldp(tab, 39) + CW_BAR; b_.x = xb_xcc_id(); b_.st = MISC + 8; xcd_barrier(b_); } } while (0);
            if (IN(23)) { PH;
                { pg8::Gemm g{R2P, WBIG_T + (size_t)2048 * 2048, NTOK, 512, 2048, 2048, 1 << 30, 0, nullptr}; pg8::StaticOrder S; S.init(NTOK, 512, G, bid); pg8::EpiRwkv E{HB, R1P, LORAP, NLAT, 8};
                  pg8::gemm_phase<pg8::EpiRwkv, pg8::StaticOrder, true, true>(lds, g, S, E, wave_s); }
                { pg8::Gemm g{xl + 1024, WR_T, NLAT, 1024, 1024, 2048, 1 << 30, 0, nullptr}; pg8::StaticOrder S; S.init(NLAT, 1024, G, bid); if (G == 256) S.skip = 64;
                  pg8::EpiBf16 E{A2P, 1024};
                  pg8::gemm_phase<pg8::EpiBf16, pg8::StaticOrder, true, true>(lds, g, S, E, wave_s); } }
            do { if (IN(23) && IN(12)) { XcdBarrier b_; b_.bar = (unsigned*)ldp(tab, 39) + CW_BAR; b_.x = xb_xcc_id(); b_.st = MISC + 8; xcd_barrier(b_); } } while (0);
            if (IN(12)) { PH;
                for (int rep = 0; rep < REP(12); ++rep) {
                { pg8::Gemm g{HB, WBIG_T, NTOK, 1024, 1024, 1024, 1 << 30, 0, nullptr}; pg8::StaticOrder S; S.init(NTOK, 1024, G, bid); pg8::EpiBf16 E{R2P, 1024};
                  pg8::gemm_phase<pg8::EpiBf16, pg8::StaticOrder, true, true>(lds, g, S, E, wave_s); }
                { pg8::Gemm g{R1P, WBIG_T + (size_t)1024 * 1024, NTOK, 1024, 1024, 1024, 1 << 30, 0, nullptr}; pg8::StaticOrder S; S.init(NTOK, 1024, G, G - 1 - bid); pg8::EpiBf16 E{R2P + (size_t)NTOK * D, 1024};
                  pg8::gemm_phase<pg8::EpiBf16, pg8::StaticOrder, true, true>(lds, g, S, E, wave_s); }
                { pg8::Gemm g{LORAP + 256, G2_T, NLAT, 1024, 256, 512, 1 << 30, 0, nullptr}; pg8::StaticOrder S; S.init(NLAT, 1024, G, bid); pg8::EpiBf16 E{xl + 1024, 2048};
                  pg8::gemm_phase<pg8::EpiBf16, pg8::StaticOrder, true, true>(lds, g, S, E, wave_s); } } }
            SEAM(12);
            if (IN(13)) { PH;
#ifdef PROBE_WKV_VARIANT
                p_wkv(A2P, R2P, R2P + (size_t)NTOK * D, LORAP, INP(24), INP(26), INP(27), INP(29), INP(32), INP(33), INP(34), HB, (size_t)NTOK * D, COEF, lds, bid, G, tid, PROBE_WKV_VARIANT);
#endif
                for (int rep = 0; rep < REP(13); ++rep) p_wkv(A2P, R2P, R2P + (size_t)NTOK * D, LORAP, INP(24), INP(26), INP(27), INP(29), INP(32), INP(33), INP(34), HB, (size_t)NTOK * D, COEF, lds, bid, G, tid); }
            SEAM(13);
            if (IN(15)) { PH; for (int rep = 0; rep < REP(15); ++rep) p_finish(HB, (size_t)NTOK * D, COEF, R2P + (size_t)NTOK * D, xl + 1024, 2048, INP(35), INP(36), A2P, gw, NGW, lane); }
            SEAM(15);
        }
        { const int ph = layer == 0 ? 4 : 16;
          if (IN(ph)) { PH; const int M = layer == 0 ? NTOK : NLAT; const bf16* A = layer == 0 ? HB : A2P; const bf16* Bt = layer == 0 ? WOUT_T : WO_T;
              pg8::Gemm g{A, Bt, M, 1024, 1024, 1024, 1 << 30, 0, nullptr}; pg8::StaticOrder S; S.init(M, 1024, G, bid);
              pg8::EpiRes E{layer == 0 ? (const void*)INP(0) : (const void*)xl, xl, (const void*)INP(2), XCP, MODACC + (size_t)layer * 33 * MODW + 2 * 1024, NLAT, SEQ, MODW, 2048, 1024, layer};
              for (int rep = 0; rep < ((layer == 0) ? REP(4) : 1); ++rep) pg8::gemm_phase<pg8::EpiRes, pg8::StaticOrder, true, true>(lds, g, S, E, wave_s); }
          SEAM(ph); }
        { const int pb = layer == 0 ? 5 : 17; const int nrows = layer == 0 ? NTOK : NLAT; const int rpe = layer == 0 ? 9216 : 8192;
          if (IN(pb)) { PH; for (int rep = 0; rep < REP(5); ++rep) p_norm_router(xl, XCP, nrows, INP(7) + layer * 1024, MODACC + (size_t)layer * 33 * MODW, INP(8) + (size_t)layer * 16384, HB, AFFL, AFFC, lds, bid, G, tid); }
          SEAM(pb);
          if (IN(pb + 1)) { PH; for (int rep = 0; rep < REP(6); ++rep) p_topk(AFFL, AFFC, layer == 0 ? 1024 : 512, rpe, STOK, SGATE, INVT, gw, NGW, lane); }
          do { if (IN(pb + 1) && IN(pb + 3)) { XcdBarrier b_; b_.bar = (unsigned*)ldp(tab, 39) + CW_BAR; b_.x = xb_xcc_id(); b_.st = MISC + 8; xcd_barrier(b_); } } while (0);
#ifdef PROBE_FP8
          if (IN(pb + 3) && layer == 0) { PH; bf16* up_t = (bf16*)(ws + WS_EW + (size_t)layer * 96 * MiB);
              pg8::Gemm g{R1P, up_t, 16 * rpe, 2048, 512, 1024, rpe / 256, (size_t)2048 * 1024 * 2, nullptr}; pg8::StaticOrder S; S.init(16 * rpe, 2048, G, bid); pg8::EpiSwiglu E{R2P, 1024};
              pg8::gemm_phase<pg8::EpiSwiglu, pg8::StaticOrder, true, true, true>(lds, g, S, E, wave_s); }
#endif
          if (IN(pb + 3)) { PH; bf16* up_t = (bf16*)(ws + WS_EW + (size_t)layer * 96 * MiB);
              pg8::Gemm g{HB, up_t, 16 * rpe, 2048, 1024, 1024, rpe / 256, (size_t)2048 * 1024 * 2, STOK}; pg8::StaticOrder S; S.init(16 * rpe, 2048, G, bid); pg8::EpiSwiglu E{R2P, 1024};
              for (int rep = 0; rep < REP(8); ++rep) pg8::gemm_phase<pg8::EpiSwiglu, pg8::StaticOrder, true, true, false, true>(lds, g, S, E, wave_s); }
          SEAM(pb + 3);
          if (IN(pb + 4)) { PH; bf16* down_t = (bf16*)(ws + WS_EW + (size_t)layer * 96 * MiB) + (size_t)16 * 2048 * 1024;
              pg8::Gemm g{R2P, down_t, 16 * rpe, 1024, 1024, 1024, rpe / 256, (size_t)1024 * 1024 * 2, nullptr}; pg8::StaticOrder S; S.init(16 * rpe, 1024, G, bid); pg8::EpiRowScale E{R1P, 1024, SGATE};
              for (int rep = 0; rep < REP(9); ++rep) pg8::gemm_phase<pg8::EpiRowScale, pg8::StaticOrder, true, true>(lds, g, S, E, wave_s); }
          SEAM(pb + 4);
          if (IN(pb + 5)) { PH; const float* modl = MODACC + (size_t)layer * 33 * MODW;
              if (layer == 0) p_combine<0>(xl, XCP, NTOK, R1P, INVT, rpe, modl, MODACC + (size_t)33 * MODW, INP(6) + 1024, R2P, gw, NGW, lane);
              else p_combine<1>(xl, XCP, NLAT, R1P, INVT, rpe, modl, modl, INP(38), R2P, gw, NGW, lane); }
          if (layer == 0) SEAM(pb + 5); }
    }
#undef IN
#undef SEAM
}

extern "C" void kernel_launch(void* const* d_in, const int* in_sizes, int n_in, void* d_out, int out_size, void* d_ws, size_t ws_size, hipStream_t stream) {
    static int grid = 0;
    if (grid == 0) {
        if (n_in != 39 || out_size != NLAT * D || ws_size < WS_END) { fprintf(stderr, "kernel_launch: unexpected problem (n_in %d out %d ws %zu)\n", n_in, out_size, ws_size); grid = -1; return; }
        int dev = 0, cus = 0, per_cu = 0;
        if (hipGetDevice(&dev) != hipSuccess || hipDeviceGetAttribute(&cus, hipDeviceAttributeMultiprocessorCount, dev) != hipSuccess) { grid = -1; return; }
        if (hipFuncSetAttribute((const void*)mk_fwd, hipFuncAttributeMaxDynamicSharedMemorySize, LDS_BYTES) != hipSuccess) { fprintf(stderr, "kernel_launch: hipFuncSetAttribute failed\n"); grid = -1; return; }
        if (hipOccupancyMaxActiveBlocksPerMultiprocessor(&per_cu, (const void*)mk_fwd, NTHR, LDS_BYTES) != hipSuccess || per_cu < 1) fprintf(stderr, "kernel_launch: occupancy query says %d\n", per_cu);
        (void)hipGetLastError();
        grid = cus;
    }
    if (grid < 0) return;
    (void)hipMemsetAsync((char*)d_ws + WS_CTL, 0, CTL_ZERO_BYTES, stream);
    Args a{};
    for (int i = 0; i < 39; ++i) a.in[i] = (const float*)d_in[i];
    a.out = (float*)d_out; a.ws = (unsigned char*)d_ws;
#if MK_PER_PHASE
    for (int i = 0; i < NPHASE; ++i) { const int k = (i <= 11) ? i : (i == 12 ? 23 : i - 1);
        a.ph_lo = k; a.ph_hi = k + 1; hipLaunchKernelGGL(mk_fwd, dim3(grid), dim3(NTHR), LDS_BYTES, stream, a); }
#else
    a.ph_lo = 0; a.ph_hi = NPHASE; hipLaunchKernelGGL(mk_fwd, dim3(grid), dim3(NTHR), LDS_BYTES, stream, a);
#endif
}
```

```cpp
#include <hip/hip_runtime.h>
#include <cstdio>
#include <cstdint>
namespace pg8 {
#define PG8_LAS __attribute__((address_space(3)))
typedef unsigned short bf16_t;
typedef short bf16x8 __attribute__((ext_vector_type(8)));
typedef float f32x4 __attribute__((ext_vector_type(4)));
typedef unsigned u32x4 __attribute__((ext_vector_type(4)));
constexpr int BM = 256, BK = 64, HALF = 128, HTB = HALF * BK * 2  , STAGE_BYTES = 8 * HTB, NXCD = 8, WGM = 8;

__host__ __device__ __forceinline__ int lds_byte(int r, int c) { const int st = (r >> 4) * 2 + (c >> 5), rr = r & 15, cc = c & 31, ob = rr * 64 + cc * 2; return st * 1024 + (ob ^ (((ob >> 9) & 1) << 5)); }
__host__ __device__ __forceinline__ void stage_rc(int b, int& R, int& C) { const int st = b / 1024, sb = b % 1024, swz = sb ^ (((sb >> 9) & 1) << 5); R = (st >> 1) * 16 + swz / 64; C = (st & 1) * 32 + (swz % 64) / 2; }
__host__ __device__ __forceinline__ int perm32(int rho) { const int n = rho >> 4, i = rho & 15; return 8 * (i >> 2) + 4 * n + (i & 3); }

struct Unit { int pm, pn; };
struct Gemm { const bf16_t* A; const bf16_t* Bt; int M, N, K; int lda; int tpg; size_t bgs; const int* gidx; };

struct StaticOrder {
    int nM, nN, nwg, G, c, skip;
    __host__ __device__ void init(int M, int N, int G_, int c_) { nM = M / BM; nN = N / BM; nwg = nM * nN; G = G_; c = c_; skip = 0; }
    __host__ __device__ bool next(int i, Unit& u) const {
        long L;
        if (skip == 0) L = (long)i * G + c;
        else { const int cp = (c - skip + G) % G; L = (c >= skip) ? (i == 0 ? (long)(c - skip) : (long)(G - skip) + (long)(i - 1) * G + cp) : (long)(G - skip) + (long)i * G + cp; }
        if (L >= nwg) return false;
        int wgid = (int)L; { const int q = nwg / NXCD, r = nwg % NXCD, xcd = wgid % NXCD, off = wgid / NXCD; wgid = (xcd < r ? xcd * (q + 1) : r * (q + 1) + (xcd - r) * q) + off; }
        const int nig = WGM * nN, gid = wgid / nig, fm = gid * WGM, gsz = (nM - fm) < WGM ? (nM - fm) : WGM;
        u.pm = fm + ((wgid % nig) % gsz); u.pn = (wgid % nig) / gsz; return true;
    }
    __device__ __forceinline__ void a_ready(const Unit&) const {}
    __device__ __forceinline__ void done(const Unit&) const {}
};

__device__ __forceinline__ unsigned cvt_pk_bf16(float lo, float hi) { unsigned r; asm volatile("v_cvt_pk_bf16_f32 %0, %1, %2" : "=v"(r) : "v"(lo), "v"(hi)); return r; }
typedef float f32x2 __attribute__((ext_vector_type(2)));
typedef float f32x2 __attribute__((ext_vector_type(2)));
typedef unsigned u32x2 __attribute__((ext_vector_type(2)));
struct EpiBf16 {
    static constexpr bool PERM = true, AFTER_DRAIN = false;
    bf16_t* O; int ldc;
    __device__ __forceinline__ void operator()(const f32x4 (&acc)[2][2][4][2], const Unit& u, int wr, int wc, int fr, int fq) const {
        const int row0 = u.pm * BM + wr * 64 + fr; const int col0 = u.pn * BM + wc * 32 + 8 * fq;
#pragma unroll
        for (int ai = 0; ai < 2; ++ai)
#pragma unroll
            for (int m = 0; m < 4; ++m) { bf16_t* rowp = O + (size_t)(row0 + ai * HALF + m * 16) * ldc + col0;
#pragma unroll
                for (int bj = 0; bj < 2; ++bj) { const f32x4 v0 = acc[ai][bj][m][0], v1 = acc[ai][bj][m][1];
                    u32x4 w; w.x = cvt_pk_bf16(v0[0], v0[1]); w.y = cvt_pk_bf16(v0[2], v0[3]); w.z = cvt_pk_bf16(v1[0], v1[1]); w.w = cvt_pk_bf16(v1[2], v1[3]);
                    *(u32x4*)(rowp + bj * HALF) = w; } }
    }
};
__device__ __forceinline__ size_t hm_block(int row, int h, int nlat) {
    if (row < nlat) { const int b = row >> 11, t = row & 2047; return ((size_t)((b * 16 + h) * 128 + (t >> 4))) * 1024; }
    const int rc = row - nlat, b = rc >> 8, t = rc & 255; return (size_t)nlat * 1024 + ((size_t)((b * 16 + h) * 16 + (t >> 4))) * 1024;
}
struct EpiHm {
    static constexpr bool PERM = true, AFTER_DRAIN = false;
    bf16_t* O; int nlat;
    __device__ __forceinline__ void operator()(const f32x4 (&acc)[2][2][4][2], const Unit& u, int wr, int wc, int fr, int fq) const {
        const int row0 = u.pm * BM + wr * 64 + fr; const int col0 = u.pn * BM + wc * 32 + 8 * fq;
#pragma unroll
        for (int ai = 0; ai < 2; ++ai)
#pragma unroll
            for (int m = 0; m < 4; ++m) { const int row = row0 + ai * HALF + m * 16;
#pragma unroll
                for (int bj = 0; bj < 2; ++bj) { const int col = col0 + bj * HALF, h = col >> 6, c = col & 63; const f32x4 v0 = acc[ai][bj][m][0], v1 = acc[ai][bj][m][1];
                    u32x4 w; w.x = cvt_pk_bf16(v0[0], v0[1]); w.y = cvt_pk_bf16(v0[2], v0[3]); w.z = cvt_pk_bf16(v1[0], v1[1]); w.w = cvt_pk_bf16(v1[2], v1[3]);
                    *(u32x4*)(O + hm_block(row, h, nlat) + (c >> 4) * 256 + (row & 15) * 16 + ((c >> 2) & 3) * 4) = w; } }
    }
};
struct EpiRowScale {
    static constexpr bool PERM = true, AFTER_DRAIN = false;
    bf16_t* O; int ldc; const float* gate;
    __device__ __forceinline__ void operator()(const f32x4 (&acc)[2][2][4][2], const Unit& u, int wr, int wc, int fr, int fq) const {
        const int row0 = u.pm * BM + wr * 64 + fr; const int col0 = u.pn * BM + wc * 32 + 8 * fq;
#pragma unroll
        for (int ai = 0; ai < 2; ++ai)
#pragma unroll
            for (int m = 0; m < 4; ++m) { const int row = row0 + ai * HALF + m * 16; const float gs = gate[row]; bf16_t* rowp = O + (size_t)row * ldc + col0;
#pragma unroll
                for (int bj = 0; bj < 2; ++bj) { const f32x4 v0 = acc[ai][bj][m][0] * gs, v1 = acc[ai][bj][m][1] * gs;
                    u32x4 w; w.x = cvt_pk_bf16(v0[0], v0[1]); w.y = cvt_pk_bf16(v0[2], v0[3]); w.z = cvt_pk_bf16(v1[0], v1[1]); w.w = cvt_pk_bf16(v1[2], v1[3]);
                    *(u32x4*)(rowp + bj * HALF) = w; } }
    }
};
struct EpiSwiglu {
    static constexpr bool PERM = true, AFTER_DRAIN = false;
    bf16_t* O; int ldc;
    __device__ __forceinline__ void operator()(const f32x4 (&acc)[2][2][4][2], const Unit& u, int wr, int wc, int fr, int fq) const {
        const int row0 = u.pm * BM + wr * 64 + fr; const int col0 = u.pn * (BM / 2) + wc * 32 + 8 * fq;
#pragma unroll
        for (int ai = 0; ai < 2; ++ai)
#pragma unroll
            for (int m = 0; m < 4; ++m) { bf16_t* rowp = O + (size_t)(row0 + ai * HALF + m * 16) * ldc + col0; float h[8];
#pragma unroll
                for (int bj = 0; bj < 2; ++bj) { const f32x4 a = acc[ai][bj][m][0], b = acc[ai][bj][m][1];
#pragma unroll
                    for (int i = 0; i < 4; ++i) h[4 * bj + i] = a[i] * __builtin_amdgcn_rcpf(1.f + __expf(-a[i])) * b[i]; }
                u32x4 w; w.x = cvt_pk_bf16(h[0], h[1]); w.y = cvt_pk_bf16(h[2], h[3]); w.z = cvt_pk_bf16(h[4], h[5]); w.w = cvt_pk_bf16(h[6], h[7]);
                *(u32x4*)rowp = w; }
    }
};
struct EpiRes {
    static constexpr bool PERM = true, AFTER_DRAIN = false;
    const void* base_l; bf16_t* out_l; const void* base_c; bf16_t* out_c; const float* gate; int nlat, rows_per_b, gstride, pl, pc, b16;
    __device__ __forceinline__ void operator()(const f32x4 (&acc)[2][2][4][2], const Unit& u, int wr, int wc, int fr, int fq) const {
        const int trow = u.pm * BM; const bool isc = trow >= nlat;
        const void* base = isc ? base_c : base_l; bf16_t* out = isc ? out_c : out_l; const int pitch = isc ? pc : pl;
        const int rbase = (isc ? trow - nlat : trow) + wr * 64 + fr; const int gb = isc ? 32 : trow / rows_per_b;
        const int col0 = u.pn * BM + wc * 32 + 8 * fq; const float* gp = gate + (size_t)gb * gstride + col0;
        f32x4 gv[4];
#pragma unroll
        for (int q = 0; q < 4; ++q) gv[q] = *(const f32x4*)(gp + (q >> 1) * HALF + (q & 1) * 4);
        if (b16) {
            u32x4 rq[4][2];
#define RESB_LOAD(slot_, gi_) do { const size_t r_ = (size_t)(rbase + ((gi_) >> 2) * HALF + ((gi_) & 3) * 16); _Pragma("unroll") for (int bj_ = 0; bj_ < 2; ++bj_) rq[slot_][bj_] = *(const u32x4*)((const bf16_t*)base + r_ * pitch + col0 + bj_ * HALF); } while (0)
            RESB_LOAD(0, 0); RESB_LOAD(1, 1); RESB_LOAD(2, 2);
#pragma unroll
            for (int gi = 0; gi < 8; ++gi) { const int ai = gi >> 2, m = gi & 3;
                if (gi + 3 < 8) RESB_LOAD((gi + 3) & 3, gi + 3);
                const size_t r = (size_t)(rbase + ai * HALF + m * 16);
#pragma unroll
                for (int bj = 0; bj < 2; ++bj) { const u32x4 p_ = rq[gi & 3][bj];
                    const f32x4 c0_ = (f32x4){__uint_as_float(p_.x << 16), __uint_as_float(p_.x & 0xffff0000u), __uint_as_float(p_.y << 16), __uint_as_float(p_.y & 0xffff0000u)};
                    const f32x4 c1_ = (f32x4){__uint_as_float(p_.z << 16), __uint_as_float(p_.z & 0xffff0000u), __uint_as_float(p_.w << 16), __uint_as_float(p_.w & 0xffff0000u)};
                    const f32x4 o0 = c0_ + gv[2 * bj] * acc[ai][bj][m][0], o1 = c1_ + gv[2 * bj + 1] * acc[ai][bj][m][1];
                    u32x4 w; w.x = cvt_pk_bf16(o0[0], o0[1]); w.y = cvt_pk_bf16(o0[2], o0[3]); w.z = cvt_pk_bf16(o1[0], o1[1]); w.w = cvt_pk_bf16(o1[2], o1[3]); *(u32x4*)(out + r * pitch + col0 + bj * HALF) = w; }
                asm volatile("" ::: "memory"); }
#undef RESB_LOAD
            return;
        }
        f32x4 fbq[4][2];
#define RESF_LOAD(slot_, hs_) do { const int gi_ = (hs_) >> 1, bj_ = (hs_) & 1; const size_t r_ = (size_t)(rbase + (gi_ >> 2) * HALF + (gi_ & 3) * 16); const int c_ = col0 + bj_ * HALF; \
            fbq[slot_][0] = *(const f32x4*)((const float*)base + r_ * 1024 + c_); fbq[slot_][1] = *(const f32x4*)((const float*)base + r_ * 1024 + c_ + 4); } while (0)
        RESF_LOAD(0, 0); RESF_LOAD(1, 1); RESF_LOAD(2, 2);
#pragma unroll
        for (int hs = 0; hs < 16; ++hs) { const int gi = hs >> 1, bj = hs & 1, ai = gi >> 2, m = gi & 3;
            if (hs + 3 < 16) RESF_LOAD((hs + 3) & 3, hs + 3);
            const size_t r = (size_t)(rbase + ai * HALF + m * 16);
            const f32x4 o0 = fbq[hs & 3][0] + gv[2 * bj] * acc[ai][bj][m][0], o1 = fbq[hs & 3][1] + gv[2 * bj + 1] * acc[ai][bj][m][1];
            u32x4 w; w.x = cvt_pk_bf16(o0[0], o0[1]); w.y = cvt_pk_bf16(o0[2], o0[3]); w.z = cvt_pk_bf16(o1[0], o1[1]); w.w = cvt_pk_bf16(o1[2], o1[3]); *(u32x4*)(out + r * pitch + col0 + bj * HALF) = w;
            asm volatile("" ::: "memory"); }
#undef RESF_LOAD
    }
};
struct EpiRwkv {
    static constexpr bool PERM = true, AFTER_DRAIN = false;
    bf16_t* Kb; bf16_t* V; bf16_t* L; int nlat; int pn_off; int ntok;
    __device__ __forceinline__ void operator()(const f32x4 (&acc)[2][2][4][2], const Unit& u0, int wr, int wc, int fr, int fq) const {
        Unit u; u.pm = u0.pm; u.pn = u0.pn + pn_off;
        const int row0 = u.pm * BM + wr * 64 + fr; const int lc0 = wc * 32 + 8 * fq;
        if (u.pn < 8) {
            const int t = u.pn >> 2;
            bf16_t* const pk = Kb; bf16_t* const pv = V;
            bf16_t* base = (t == 0) ? pk : pv; base += (u.pn & 3) * BM + lc0;
            {
#pragma unroll
            for (int ai = 0; ai < 2; ++ai)
#pragma unroll
                for (int m = 0; m < 4; ++m) { bf16_t* rowp = base + (size_t)(row0 + ai * HALF + m * 16) * 1024;
#pragma unroll
                    for (int bj = 0; bj < 2; ++bj) { const f32x4 v0 = acc[ai][bj][m][0], v1 = acc[ai][bj][m][1];
                        u32x4 w; w.x = cvt_pk_bf16(v0[0], v0[1]); w.y = cvt_pk_bf16(v0[2], v0[3]); w.z = cvt_pk_bf16(v1[0], v1[1]); w.w = cvt_pk_bf16(v1[2], v1[3]);
                        *(u32x4*)(rowp + bj * HALF) = w; } } }
        } else {
            const bool sig = (u.pn == 9);
#pragma unroll
            for (int ai = 0; ai < 2; ++ai)
#pragma unroll
                for (int m = 0; m < 4; ++m) { const int row = row0 + ai * HALF + m * 16;
#pragma unroll
                    for (int bj = 0; bj < 2; ++bj) { const f32x4 v0 = acc[ai][bj][m][0], v1 = acc[ai][bj][m][1]; const int col = lc0 + bj * HALF, pc = col >> 6, jj = col & 63;
                        bf16_t* rowp = sig ? L + (size_t)row * 256 + lc0
                                           : L + (size_t)ntok * 256 + ((size_t)pc * ntok + (row & ~15)) * 64 + (jj >> 5) * 512 + (row & 15) * 32 + ((jj >> 3) & 3) * 8 - bj * HALF;
                        float f[8] = {v0[0], v0[1], v0[2], v0[3], v1[0], v1[1], v1[2], v1[3]};
#pragma unroll
                        for (int i = 0; i < 8; ++i) { const float x = f[i]; const float sg = __builtin_amdgcn_rcpf(1.f + __expf(-x)); const float th = 1.f - 2.f * __builtin_amdgcn_rcpf(1.f + __expf(2.f * x)); f[i] = sig ? sg : (bj == 0 ? th : x); }
                        u32x4 w; w.x = cvt_pk_bf16(f[0], f[1]); w.y = cvt_pk_bf16(f[2], f[3]); w.z = cvt_pk_bf16(f[4], f[5]); w.w = cvt_pk_bf16(f[6], f[7]);
                        *(u32x4*)(rowp + bj * HALF) = w; } }
        }
    }
};
template <class Epi, class Sched, bool ALIGN_EPI = false, bool SP2 = false, bool FP8 = false, bool GATHER = false>
__device__ __forceinline__ void gemm_phase(PG8_LAS unsigned char* lds, const Gemm g, const Sched& S, const Epi& E, const int wave_s) {
    int lid_; asm volatile("v_mbcnt_lo_u32_b32 %0, -1, 0\n\tv_mbcnt_hi_u32_b32 %0, -1, %0" : "=v"(lid_)); int tid_ = (wave_s << 6) | lid_;
    const int tid = tid_, wid = __builtin_amdgcn_readfirstlane(tid >> 6), lane = tid & 63, wr = wid >> 2, wc = wid & 3, fr = lane & 15, fq = lane >> 4;
    const int K = g.K, nt = K / BK;
    unsigned voffA[2], voffB[2];
#pragma unroll
    for (int i = 0; i < 2; ++i) { int R, C; stage_rc(tid * 16 + i * 8192, R, C); const int Rb = Epi::PERM ? ((R & ~31) + perm32(R & 31)) : R;
        voffA[i] = (unsigned)(R * g.lda + C) * 2u; voffB[i] = (unsigned)(Rb * K + C) * 2u; }
    unsigned gC[2] = {0u, 0u}, cg0[2] = {0u, 0u}, cg1[2] = {0u, 0u}, ng0[2] = {0u, 0u}, ng1[2] = {0u, 0u};
    if constexpr (GATHER) { static_assert(SP2, "GATHER is wired into the SP2 loop only");
#pragma unroll
        for (int i = 0; i < 2; ++i) { int R, C; stage_rc(tid * 16 + i * 8192, R, C); gC[i] = (unsigned)C * 2u; } }
    typedef int i32x16 __attribute__((ext_vector_type(16)));
#define PG8_GIDX(pm_, o0_, o1_) do { const int rb_ = (pm_) * BM + 16 * (wid >> 1); const int sel_ = lane >> 2; \
        _Pragma("unroll") for (int j_ = 0; j_ < 4; ++j_) { const i32x16 s_ = *(const __attribute__((address_space(4))) i32x16*)(g.gidx + rb_ + 64 * j_); int r_ = s_[0]; \
            _Pragma("unroll") for (int k_ = 1; k_ < 16; ++k_) r_ = (sel_ == k_) ? s_[k_] : r_; \
            const unsigned off_ = (unsigned)r_ * (unsigned)(g.lda * 2) + gC[j_ & 1]; if (j_ < 2) o0_[j_ & 1] = off_; else o1_[j_ & 1] = off_; } } while (0)
    const size_t kstep = (size_t)(BK * 2);
    const size_t hA = (size_t)HALF * g.lda * 2, hB = (size_t)HALF * K * 2;
    const size_t tA = 2 * hA, tB = 2 * hB;
    const unsigned ldsw = (unsigned)wid * 1024u;
    const int aoff = lds_byte(wr * 64 + fr, fq * 8), boff = lds_byte(wc * 32 + fr, fq * 8);
#define PG8_SA(b, h) (((b) * 2 + (h)) * HTB)
#define PG8_SB(b, h) ((4 + (b) * 2 + (h)) * HTB)
#define PG8_STAGE(bufoff, gbase, voff) do { _Pragma("unroll") for (int _i = 0; _i < 2; ++_i) \
        __builtin_amdgcn_global_load_lds((const unsigned*)((const char*)(gbase) + (voff)[_i]), (PG8_LAS unsigned*)(lds + (bufoff) + ldsw + _i * 8192), 16, 0, 0); } while (0)
#define PG8_LDA(dst, b, h) do { _Pragma("unroll") for (int m = 0; m < 4; ++m) _Pragma("unroll") for (int k = 0; k < 2; ++k) dst[m][k] = *(const PG8_LAS bf16x8*)(lds + PG8_SA(b, h) + aoff + m * 2048 + k * 1024); } while (0)
#define PG8_LDB(dst, b, h) do { _Pragma("unroll") for (int n = 0; n < 2; ++n) _Pragma("unroll") for (int k = 0; k < 2; ++k) dst[n][k] = *(const PG8_LAS bf16x8*)(lds + PG8_SB(b, h) + boff + n * 2048 + k * 1024); } while (0)
#define PG8_MMA(ai, bj, At, Bt) do { __builtin_amdgcn_s_setprio(1); _Pragma("unroll") for (int m = 0; m < 4; ++m) _Pragma("unroll") for (int n = 0; n < 2; ++n) _Pragma("unroll") for (int k = 0; k < 2; ++k) { \
        if constexpr (FP8) { typedef long l2_t __attribute__((ext_vector_type(2))); const l2_t b2_ = __builtin_bit_cast(l2_t, Bt[n][k]), a2_ = __builtin_bit_cast(l2_t, At[m][k]); \
            acc[ai][bj][m][n] = __builtin_amdgcn_mfma_f32_16x16x32_fp8_fp8(b2_[0], a2_[0], acc[ai][bj][m][n], 0, 0, 0); acc[ai][bj][m][n] = __builtin_amdgcn_mfma_f32_16x16x32_fp8_fp8(b2_[1], a2_[1], acc[ai][bj][m][n], 0, 0, 0); } \
        else acc[ai][bj][m][n] = __builtin_amdgcn_mfma_f32_16x16x32_bf16(Bt[n][k], At[m][k], acc[ai][bj][m][n], 0, 0, 0); } __builtin_amdgcn_s_setprio(0); } while (0)
#define PG8_WAIT_V(n) asm volatile("s_waitcnt vmcnt(" #n ")" ::: "memory")
#define PG8_WAIT_L(n) asm volatile("s_waitcnt lgkmcnt(" #n ")" ::: "memory")
#define PG8_BAR __builtin_amdgcn_s_barrier()
#define PG8_SCHED __builtin_amdgcn_sched_barrier(0)
    Unit cur, nxt; int ui = 0;
    if (!S.next(0, cur)) return;
    f32x4 acc[2][2][4][2];
#pragma unroll
    for (int a = 0; a < 2; ++a)
#pragma unroll
        for (int b = 0; b < 2; ++b)
#pragma unroll
            for (int m = 0; m < 4; ++m)
#pragma unroll
                for (int n = 0; n < 2; ++n) acc[a][b][m][n] = (f32x4){0.f, 0.f, 0.f, 0.f};
    bf16x8 At[4][2], B0[2][2], B1[2][2];
    const char* cA = (const char*)g.A + (GATHER ? (size_t)0 : (size_t)cur.pm * tA); if constexpr (GATHER) { PG8_GIDX(cur.pm, cg0, cg1); }
    const char* cB = (const char*)g.Bt + (size_t)(cur.pm / g.tpg) * g.bgs + (size_t)cur.pn * tB;
    S.a_ready(cur);
    if constexpr (SP2) {
        PG8_STAGE(PG8_SB(0, 0), cB, voffB); PG8_STAGE(PG8_SB(0, 1), cB + hB, voffB);
        if constexpr (GATHER) { PG8_STAGE(PG8_SA(0, 0), cA, cg0); PG8_STAGE(PG8_SA(0, 1), cA, cg1); } else { PG8_STAGE(PG8_SA(0, 0), cA, voffA); PG8_STAGE(PG8_SA(0, 1), cA + hA, voffA); }
        if (wr == 1) PG8_BAR;
        PG8_WAIT_V(2); PG8_BAR;
        PG8_STAGE(PG8_SB(1, 0), cB + kstep, voffB); if constexpr (GATHER) PG8_STAGE(PG8_SA(1, 0), cA + kstep, cg0); else PG8_STAGE(PG8_SA(1, 0), cA + kstep, voffA); PG8_STAGE(PG8_SB(1, 1), cB + hB + kstep, voffB);
        PG8_WAIT_V(6); PG8_BAR;
    } else {
        PG8_STAGE(PG8_SB(0, 0), cB, voffB); PG8_STAGE(PG8_SA(0, 0), cA, voffA); PG8_STAGE(PG8_SB(0, 1), cB + hB, voffB); PG8_STAGE(PG8_SA(0, 1), cA + hA, voffA);
        if (wr == 1) PG8_BAR;
        PG8_WAIT_V(4); PG8_BAR;
        PG8_STAGE(PG8_SB(1, 0), cB + kstep, voffB); PG8_STAGE(PG8_SA(1, 0), cA + kstep, voffA); PG8_STAGE(PG8_SB(1, 1), cB + hB + kstep, voffB);
        PG8_WAIT_V(6); PG8_BAR;
    }
    for (;;) {
        const bool has_next = S.next(ui + 1, nxt);
        if constexpr (GATHER) { if (has_next) { PG8_GIDX(nxt.pm, ng0, ng1); } else { ng0[0] = cg0[0]; ng0[1] = cg0[1]; ng1[0] = cg1[0]; ng1[1] = cg1[1]; } }
        const char* nA = GATHER ? cA : (has_next ? (const char*)g.A + (size_t)nxt.pm * tA : cA); const char* nB = has_next ? (const char*)g.Bt + (size_t)(nxt.pm / g.tpg) * g.bgs + (size_t)nxt.pn * tB : cB;
        for (int t = 0; t < nt; t += 2) {
            const bool last = (t == nt - 2);
            const char* a1 = cA + (size_t)(t + 1) * kstep;
            const char* a2 = last ? nA : cA + (size_t)(t + 2) * kstep; const char* b2 = last ? nB : cB + (size_t)(t + 2) * kstep;
            const char* a3 = a2 + kstep; const char* b3 = b2 + kstep;
            if (last && has_next) S.a_ready(nxt);
            if constexpr (SP2) {
            PG8_LDB(B0, 0, 0); PG8_LDB(B1, 0, 1); PG8_SCHED; PG8_LDA(At, 0, 0); if constexpr (GATHER) { PG8_STAGE(PG8_SA(1, 1), a1, cg1); if (last) { cg0[0] = ng0[0]; cg0[1] = ng0[1]; cg1[0] = ng1[0]; cg1[1] = ng1[1]; } }
            else PG8_STAGE(PG8_SA(1, 1), a1 + hA, voffA);
            PG8_WAIT_V(8); PG8_WAIT_L(0); PG8_BAR; PG8_MMA(0, 0, At, B0); PG8_MMA(0, 1, At, B1); PG8_BAR; PG8_SCHED;
            PG8_LDA(At, 0, 1); PG8_STAGE(PG8_SB(0, 0), b2, voffB); PG8_STAGE(PG8_SB(0, 1), b2 + hB, voffB); if constexpr (GATHER) PG8_STAGE(PG8_SA(0, 0), a2, cg0); else PG8_STAGE(PG8_SA(0, 0), a2, voffA);
            PG8_WAIT_V(8); PG8_WAIT_L(0); PG8_BAR; PG8_MMA(1, 0, At, B0); PG8_MMA(1, 1, At, B1); PG8_BAR; PG8_SCHED;
            PG8_LDB(B0, 1, 0); PG8_LDB(B1, 1, 1); PG8_SCHED; PG8_LDA(At, 1, 0); if constexpr (GATHER) PG8_STAGE(PG8_SA(0, 1), a2, cg1); else PG8_STAGE(PG8_SA(0, 1), a2 + hA, voffA);
            PG8_WAIT_V(8); PG8_WAIT_L(0); PG8_BAR; PG8_MMA(0, 0, At, B0); PG8_MMA(0, 1, At, B1); PG8_BAR; PG8_SCHED;
            PG8_LDA(At, 1, 1); PG8_STAGE(PG8_SB(1, 0), b3, voffB); PG8_STAGE(PG8_SB(1, 1), b3 + hB, voffB); if constexpr (GATHER) PG8_STAGE(PG8_SA(1, 0), a3, cg0); else PG8_STAGE(PG8_SA(1, 0), a3, voffA);
            PG8_WAIT_V(8); PG8_WAIT_L(0); PG8_BAR; PG8_MMA(1, 0, At, B0); PG8_MMA(1, 1, At, B1); PG8_BAR; PG8_SCHED;
            } else {
            PG8_LDB(B0, 0, 0); PG8_SCHED; PG8_LDA(At, 0, 0); PG8_STAGE(PG8_SA(1, 1), a1 + hA, voffA);
            PG8_WAIT_L(8); PG8_BAR; PG8_WAIT_L(0); PG8_MMA(0, 0, At, B0); PG8_BAR; PG8_SCHED;
            PG8_LDB(B1, 0, 1); PG8_STAGE(PG8_SB(0, 0), b2, voffB);
            PG8_BAR; PG8_WAIT_L(0); PG8_MMA(0, 1, At, B1); PG8_BAR;
            PG8_LDA(At, 0, 1); PG8_STAGE(PG8_SA(0, 0), a2, voffA);
            PG8_BAR; PG8_WAIT_L(0); PG8_MMA(1, 0, At, B0); PG8_BAR; PG8_SCHED;
            PG8_STAGE(PG8_SB(0, 1), b2 + hB, voffB);
            PG8_WAIT_V(6); PG8_BAR; PG8_MMA(1, 1, At, B1); PG8_BAR;
            PG8_LDB(B0, 1, 0); PG8_SCHED; PG8_LDA(At, 1, 0); PG8_STAGE(PG8_SA(0, 1), a2 + hA, voffA);
            PG8_WAIT_L(8); PG8_BAR; PG8_WAIT_L(0); PG8_MMA(0, 0, At, B0); PG8_BAR; PG8_SCHED;
            PG8_LDB(B1, 1, 1); PG8_STAGE(PG8_SB(1, 0), b3, voffB);
            PG8_BAR; PG8_WAIT_L(0); PG8_MMA(0, 1, At, B1); PG8_BAR;
            PG8_LDA(At, 1, 1); PG8_STAGE(PG8_SA(1, 0), a3, voffA);
            PG8_BAR; PG8_WAIT_L(0); PG8_MMA(1, 0, At, B0); PG8_BAR; PG8_SCHED;
            PG8_STAGE(PG8_SB(1, 1), b3 + hB, voffB);
            PG8_WAIT_V(6); PG8_BAR; PG8_MMA(1, 1, At, B1); PG8_BAR;
            }
        }
        if constexpr (ALIGN_EPI) { if (wr == 0) PG8_BAR; }
        if constexpr (!Epi::AFTER_DRAIN) { E(acc, cur, wr, wc, fr, fq); S.done(cur); }
        if (!has_next) break;
#pragma unroll
        for (int a = 0; a < 2; ++a)
#pragma unroll
            for (int b = 0; b < 2; ++b)
#pragma unroll
                for (int m = 0; m < 4; ++m)
#pragma unroll
                    for (int n = 0; n < 2; ++n) acc[a][b][m][n] = (f32x4){0.f, 0.f, 0.f, 0.f};
        cur = nxt; cA = nA; cB = nB; ++ui;
        if constexpr (ALIGN_EPI) { if (wr == 1) PG8_BAR; }
    }
    PG8_WAIT_V(0);
    if constexpr (!ALIGN_EPI) { if (wr == 0) PG8_BAR; }
    PG8_BAR;
    if constexpr (Epi::AFTER_DRAIN) { E.fused(acc, cur, wr, wc, fr, fq, lds, wid, lane); S.done(cur); }
#undef PG8_SA
#undef PG8_SB
#undef PG8_STAGE
#undef PG8_GIDX
#undef PG8_LDA
#undef PG8_LDB
#undef PG8_MMA
#undef PG8_WAIT_V
#undef PG8_WAIT_L
#undef PG8_BAR
#undef PG8_SCHED
}
}
#define GAS __attribute__((address_space(1)))
#define LAS __attribute__((address_space(3)))
typedef unsigned short bf16;
typedef unsigned v4u __attribute__((ext_vector_type(4)));
typedef unsigned v2u __attribute__((ext_vector_type(2)));
typedef float f32x4 __attribute__((ext_vector_type(4)));
typedef float f32x2 __attribute__((ext_vector_type(2)));
typedef GAS unsigned gu32;
#define RLX_AGENT __ATOMIC_RELAXED, __HIP_MEMORY_SCOPE_AGENT
#define LDS_WAIT() asm volatile("s_waitcnt lgkmcnt(0)" ::: "memory")
#define VM_WAIT() asm volatile("s_waitcnt vmcnt(0)" ::: "memory")

#define XB_TMO      128
#define XB_XCNT(j)  (256  + 64 * (j))
#define XB_XSUB(j)  (1280 + 64 * (j))
#define XB_XGEN(j)  (2304 + 64 * (j))
#define XB_TOP      3328
#define XB_TOPGEN   3392
#define XCD_BAR_WORDS 3456
#define XB_SPIN_CAP (1u << 18)

__device__ __forceinline__ unsigned xb_ld(unsigned* p)              { return __hip_atomic_load(p, __ATOMIC_RELAXED, __HIP_MEMORY_SCOPE_AGENT); }
__device__ __forceinline__ unsigned xb_add(unsigned* p, unsigned v) { return __hip_atomic_fetch_add(p, v, __ATOMIC_RELAXED, __HIP_MEMORY_SCOPE_AGENT); }
__device__ __forceinline__ unsigned xb_xcc_id() { return (unsigned)__builtin_amdgcn_s_getreg((3 << 11) | 20) & 0xFu; }
#define XB_SPIN(cond, bar) do { unsigned _sp = 0; while (cond) { __builtin_amdgcn_s_sleep(1); \
    if ((++_sp & 255u) == 0u) { if (xb_ld(&(bar)[XB_TMO])) break; if (_sp > XB_SPIN_CAP) { atomicAdd(&(bar)[XB_TMO], 1u); break; } } } } while (0)

struct XcdBarrier {
    unsigned* bar; unsigned x;
    volatile LAS unsigned* st;
};

__device__ __forceinline__ XcdBarrier xcd_barrier_post(unsigned* bar, volatile LAS unsigned* st) {
    XcdBarrier b; b.bar = bar; b.x = xb_xcc_id(); b.st = st;
    if (threadIdx.x == 0) (void)xb_add(&bar[XB_XCNT(b.x)], 1u);
    return b;
}
__device__ __forceinline__ void xcd_barrier_complete(unsigned* bar, unsigned x, unsigned& nloc, unsigned& nx) {
    const unsigned G = gridDim.x * gridDim.y * gridDim.z;
    unsigned sum, cnt, mine, sp = 0u;
    for (;;) {
        sum = 0u; cnt = 0u; mine = 0u;
#pragma unroll
        for (unsigned j = 0; j < 16; ++j) { const unsigned c = xb_ld(&bar[XB_XCNT(j)]); sum += c; cnt += (c > 0u) ? 1u : 0u; mine = (j == x) ? c : mine; }
        if (sum == G) break;
        __builtin_amdgcn_s_sleep(1);
        if ((++sp & 255u) == 0u) { if (xb_ld(&bar[XB_TMO])) break; if (sp > XB_SPIN_CAP) { atomicAdd(&bar[XB_TMO], 1u); break; } }
    }
    nloc = mine > 0u ? mine : 1u; nx = cnt > 0u ? cnt : 1u;
}

__device__ __forceinline__ void xcd_barrier(const XcdBarrier& b) {
    asm volatile("s_waitcnt vmcnt(0)" ::: "memory");
    __syncthreads();
    if (threadIdx.x == 0) {
        unsigned* bar = b.bar;
        __builtin_amdgcn_s_waitcnt(0);
        unsigned nloc = b.st[0], nx = b.st[1];
        if (nloc == 0u) { xcd_barrier_complete(bar, b.x, nloc, nx); b.st[0] = nloc; b.st[1] = nx; }
        const unsigned old = xb_add(&bar[XB_XSUB(b.x)], 1u);
        const unsigned gen = old / nloc;
        if (old + 1u == (gen + 1u) * nloc) {
            __builtin_amdgcn_fence(__ATOMIC_RELEASE, "agent");
            asm volatile("s_waitcnt vmcnt(0)" ::: "memory");
            const unsigned og = xb_add(&bar[XB_TOP], 1u);
            const unsigned tg = og / nx;
            if (og + 1u == (tg + 1u) * nx) xb_add(&bar[XB_TOPGEN], 1u);
            else XB_SPIN(xb_ld(&bar[XB_TOPGEN]) == tg, bar);
            __builtin_amdgcn_fence(__ATOMIC_ACQUIRE, "agent");
            xb_add(&bar[XB_XGEN(b.x)], 1u);
            asm volatile("s_waitcnt vmcnt(0)" ::: "memory");
        } else {
            XB_SPIN(xb_ld(&bar[XB_XGEN(b.x)]) == gen, bar);
            __builtin_amdgcn_fence(__ATOMIC_ACQUIRE, "agent");
            asm volatile("s_waitcnt vmcnt(0)" ::: "memory");
        }
    }
    __syncthreads();
}
constexpr int D = 1024, NB = 32, SEQ = 2048, CTXL = 256, NLAT = NB * SEQ, NCTX = NB * CTXL, NTOK = NLAT + NCTX;
constexpr int QW = 1792;
constexpr int NE = 16, NWAVES = 8, NTHR = 512, MODW = 6144;
constexpr size_t MiB = 1u << 20;
constexpr size_t WS_CTL = 0, WS_MOD = 1 * MiB, CTL_ZERO_BYTES = 3 * MiB;
constexpr size_t WS_ROPE = 3 * MiB;
constexpr size_t WS_AFFL = 4 * MiB, WS_AFFC = 8 * MiB;
constexpr size_t WS_STOK = 9 * MiB, WS_SGATE = 10 * MiB, WS_INV = 11 * MiB;
constexpr size_t WS_STOK1 = 13 * MiB + 512 * 1024;
constexpr size_t WS_COEF = 14 * MiB;
constexpr size_t WS_WIN = 22 * MiB, WS_WOUT = 26 * MiB, WS_WBIG = 28 * MiB, WS_WR = 40 * MiB, WS_G2 = 42 * MiB, WS_WO = 43 * MiB;
constexpr size_t WS_EW = 46 * MiB;
constexpr size_t WS_LORA = 46 * MiB;
constexpr size_t WS_XC = 238 * MiB;
constexpr size_t WS_H = 270 * MiB, WS_R1 = 414 * MiB, WS_R2 = 702 * MiB, WS_END = 990 * MiB;
constexpr int CW_BAR = 4096;
constexpr int CTRL_BASE = 146688, LDS_BYTES = 147456, MISC_OFF = CTRL_BASE, TAB_OFF = CTRL_BASE + 64;

__device__ __forceinline__ int opaque_tid(int wave_s) { int l; asm volatile("v_mbcnt_lo_u32_b32 %0, -1, 0\n\tv_mbcnt_hi_u32_b32 %0, -1, %0" : "=v"(l)); return (wave_s << 6) | l; }
typedef __bf16 bf16x2_t __attribute__((ext_vector_type(2)));
__device__ __forceinline__ unsigned pkbf(float lo, float hi) { const f32x2 v = {lo, hi}; const bf16x2_t b = __builtin_convertvector(v, bf16x2_t); return __builtin_bit_cast(unsigned, b); }
__device__ __forceinline__ float bflo(unsigned u) { return __uint_as_float(u << 16); }
__device__ __forceinline__ float bfhi(unsigned u) { return __uint_as_float(u & 0xffff0000u); }
__device__ __forceinline__ void unpack8(const v4u p, float (&f)[8]) { f[0] = bflo(p.x); f[1] = bfhi(p.x); f[2] = bflo(p.y); f[3] = bfhi(p.y); f[4] = bflo(p.z); f[5] = bfhi(p.z); f[6] = bflo(p.w); f[7] = bfhi(p.w); }
__device__ __forceinline__ v4u pack8(const float (&f)[8]) { v4u w; w.x = pkbf(f[0], f[1]); w.y = pkbf(f[2], f[3]); w.z = pkbf(f[4], f[5]); w.w = pkbf(f[6], f[7]); return w; }
__device__ __forceinline__ float sigmoidf_(float x) { return 1.f / (1.f + expf(-x)); }
__device__ __forceinline__ float sigmoid_fast(float x) { return __builtin_amdgcn_rcpf(1.f + __expf(-x)); }
__device__ __forceinline__ float softplusf_(float x) { return fmaxf(x, 0.f) + log1pf(expf(-fabsf(x))); }
__device__ __forceinline__ float gelu_tanh(float x) { return 0.5f * x * (1.f + tanhf(0.7978845608028654f * (x + 0.044715f * x * x * x))); }
template <int CTRL> __device__ __forceinline__ float dppmov(float v) { return __builtin_bit_cast(float, __builtin_amdgcn_update_dpp(0, __builtin_bit_cast(int, v), CTRL, 0xF, 0xF, true)); }
__device__ __forceinline__ float sum4(float v) { v += dppmov<0xB1>(v); v += dppmov<0x4E>(v); return v; }
__device__ __forceinline__ float rows_sum(float v) {
    float a = v, b;
    asm volatile("v_mov_b32 %1, %0\n\ts_nop 1\n\tv_permlane16_swap_b32 %0, %1\n\ts_nop 1" : "+v"(a), "=&v"(b));
    a += b;
    asm volatile("v_mov_b32 %1, %0\n\ts_nop 1\n\tv_permlane32_swap_b32 %0, %1\n\ts_nop 1" : "+v"(a), "=&v"(b));
    return a + b;
}
__device__ __forceinline__ float wave_sum(float v) {
    v += dppmov<0xB1>(v); v += dppmov<0x4E>(v); v += dppmov<0x141>(v); v += dppmov<0x140>(v);
    return rows_sum(v);
}
__device__ __forceinline__ int wave_sum_i(int v) {
    v += __builtin_amdgcn_update_dpp(0, v, 0xB1, 0xF, 0xF, true); v += __builtin_amdgcn_update_dpp(0, v, 0x4E, 0xF, 0xF, true); v += __builtin_amdgcn_update_dpp(0, v, 0x141, 0xF, 0xF, true); v += __builtin_amdgcn_update_dpp(0, v, 0x140, 0xF, 0xF, true);
    int a = v, b;
    asm volatile("v_mov_b32 %1, %0\n\ts_nop 1\n\tv_permlane16_swap_b32 %0, %1\n\ts_nop 1" : "+v"(a), "=&v"(b));
    a += b;
    asm volatile("v_mov_b32 %1, %0\n\ts_nop 1\n\tv_permlane32_swap_b32 %0, %1\n\ts_nop 1" : "+v"(a), "=&v"(b));
    return a + b;
}
__device__ __forceinline__ float sum8(float v) { v = sum4(v); v += dppmov<0x141>(v); return v; }

__device__ __forceinline__ void p_mods(const float* c, const float* cc, const float* mod_w, const float* mod_b, float* modacc, LAS unsigned char* lds, int bid, int G, int tid) {
    LAS float* S = (LAS float*)lds;
    const int wave = tid >> 6, lane = tid & 63;
    for (int it = bid; it < 192; it += G) {
        const int l = it / 96, n0 = (it % 96) * 64;
        __syncthreads();
        for (int i = tid; i < 33 * 1024; i += NTHR) { const int row = i >> 10, k = i & 1023; const float v = row < 32 ? c[row * 1024 + k] : cc[k]; S[i] = v / (1.f + expf(-v)); }
        __syncthreads();
        float acc[33];
#pragma unroll
        for (int row = 0; row < 33; ++row) acc[row] = 0.f;
        const float* W = mod_w + ((size_t)l * 1024 + wave * 128) * MODW + n0 + lane;
#pragma unroll 1
        for (int kb = 0; kb < 128; kb += 16) {
            float w[16];
#pragma unroll
            for (int i = 0; i < 16; ++i) w[i] = W[(size_t)(kb + i) * MODW];
#pragma unroll
            for (int i = 0; i < 16; i += 4) {
#pragma unroll
                for (int row = 0; row < 33; ++row) { const f32x4 s = *(const LAS f32x4*)(S + row * 1024 + wave * 128 + kb + i); acc[row] += s.x * w[i] + s.y * w[i + 1] + s.z * w[i + 2] + s.w * w[i + 3];
                    if (row % 6 == 5) asm volatile("" : "+v"(acc[row]) :: "memory"); } }
        }
        __syncthreads();
#pragma unroll
        for (int row = 0; row < 33; ++row) S[(wave * 33 + row) * 64 + lane] = acc[row];
        __syncthreads();
        for (int row = wave; row < 33; row += NWAVES) { float v = mod_b[l * MODW + n0 + lane];
#pragma unroll
            for (int j = 0; j < 8; ++j) v += S[(j * 33 + row) * 64 + lane];
            modacc[(size_t)(l * 33 + row) * MODW + n0 + lane] = v; }
    }
}
__device__ __forceinline__ void conv_items(const float* src, int K, int N, int nmat, size_t sms, bf16* dst, size_t dms, int pitch, int koff, int Kpad, int mode, int row_off,
                                           const float* mu, int smode, LAS float* scr, int gw, int NGW, int lane, int gstart, int& gcount, int variant = 0) {
    if ((N & 63) == 0) {
        const int nkb = Kpad / 64, nnb = N / 64, ipm = nkb * nnb, total = ipm * nmat; gcount = total;
        int first = (gw - gstart) % NGW; if (first < 0) first += NGW;
        for (int it = first; it < total; it += NGW) {
            const int mat = it / ipm, r = it % ipm, kb = r / nnb, nb = r % nnb, k0 = kb * 64, n0 = nb * 64;
            const float* W = src + (size_t)mat * sms; bf16* O = dst + (size_t)mat * dms;
            { f32x2 v[32]; const float* Wp = W + (size_t)(k0 + (lane >> 5)) * N + n0 + 2 * (lane & 31);
              if (variant == 2) {
#pragma unroll
                  for (int i = 0; i < 32; ++i) v[i] = (f32x2){0.f, 0.f};
              } else if (k0 + 64 <= K) {
#pragma unroll
                  for (int i = 0; i < 32; ++i) v[i] = *(const f32x2*)(Wp + (size_t)(2 * i) * N);
              } else {
#pragma unroll
                  for (int i = 0; i < 32; ++i) v[i] = (k0 + 2 * i + (lane >> 5) < K) ? *(const f32x2*)(Wp + (size_t)(2 * i) * N) : (f32x2){0.f, 0.f};
              }
              if (smode != 0) { const float* mp = mu + k0 + (lane >> 5);
#pragma unroll
                  for (int i = 0; i < 32; ++i) { const float mm = mp[2 * i]; v[i] *= (smode == 1) ? (1.f - mm) : mm; } }
#pragma unroll
              for (int i = 0; i < 32; ++i) { LAS float* sp = scr + (2 * i + (lane >> 5)) * 65 + 2 * (lane & 31); sp[0] = v[i].x; sp[1] = v[i].y; } }
            LDS_WAIT(); asm volatile("" ::: "memory");
            const int c = lane & 7;
#pragma unroll
            for (int j = 0; j < 8; ++j) { const int n = (lane >> 3) + 8 * j, gn = n0 + n; const int row = (mode == 0) ? row_off + gn : row_off + ((gn >> 7) << 8) + (((gn >> 2) & 1) << 7) + (((gn >> 5) & 3) << 5) + (((gn >> 3) & 3) << 3) + (gn & 3);
                const LAS float* s = scr + (8 * c) * 65 + n;
                v4u o; o.x = pkbf(s[0 * 65], s[1 * 65]); o.y = pkbf(s[2 * 65], s[3 * 65]); o.z = pkbf(s[4 * 65], s[5 * 65]); o.w = pkbf(s[6 * 65], s[7 * 65]);
                if (variant != 1 || o.x == 0x12345678u) *(v4u*)(O + (size_t)row * pitch + koff + k0 + 8 * c) = o; }
            LDS_WAIT(); asm volatile("" ::: "memory");
        }
        return;
    }
    const int nkb = Kpad / 64, nnb = N / 32, ipm = nkb * nnb, total = ipm * nmat; gcount = total;
    int first = (gw - gstart) % NGW; if (first < 0) first += NGW;
    for (int it = first; it < total; it += NGW) {
        const int mat = it / ipm, r = it % ipm, kb = r / nnb, nb = r % nnb, k0 = kb * 64, n0 = nb * 32;
        const float* W = src + (size_t)mat * sms; bf16* O = dst + (size_t)mat * dms;
        { float v[32]; const float* Wp = W + (size_t)(k0 + (lane >> 5)) * N + n0 + (lane & 31);
          if (k0 + 64 <= K) {
#pragma unroll
              for (int i = 0; i < 32; ++i) v[i] = Wp[(size_t)(2 * i) * N];
          } else {
#pragma unroll
              for (int i = 0; i < 32; ++i) v[i] = (k0 + 2 * i + (lane >> 5) < K) ? Wp[(size_t)(2 * i) * N] : 0.f;
          }
          if (smode != 0) { const float* mp = mu + k0 + (lane >> 5);
#pragma unroll
              for (int i = 0; i < 32; ++i) { const float mm = mp[2 * i]; v[i] *= (smode == 1) ? (1.f - mm) : mm; } }
#pragma unroll
          for (int i = 0; i < 32; ++i) scr[(2 * i + (lane >> 5)) * 33 + (lane & 31)] = v[i]; }
        LDS_WAIT(); asm volatile("" ::: "memory");
        const int c = lane & 7;
#pragma unroll
        for (int j = 0; j < 4; ++j) { const int n = (lane >> 3) + 8 * j, gn = n0 + n; const int row = (mode == 0) ? row_off + gn : row_off + ((gn >> 7) << 8) + (((gn >> 2) & 1) << 7) + (((gn >> 5) & 3) << 5) + (((gn >> 3) & 3) << 3) + (gn & 3);
            const LAS float* s = scr + (8 * c) * 33 + n;
            v4u o; o.x = pkbf(s[0 * 33], s[1 * 33]); o.y = pkbf(s[2 * 33], s[3 * 33]); o.z = pkbf(s[4 * 33], s[5 * 33]); o.w = pkbf(s[6 * 33], s[7 * 33]);
            *(v4u*)(O + (size_t)row * pitch + koff + k0 + 8 * c) = o; }
        LDS_WAIT(); asm volatile("" ::: "memory");
    }
}

__device__ __forceinline__ void conv_block_items(const float* src, int K, int N, int nmat, size_t sms, bf16* dst, size_t dms, int pitch, int koff, int mode, int row_off,
                                                 const float* mu, int smode, LAS unsigned char* lds, int bid, int G, int tid, int gstart, int& gcount) {
    const int nkb = K / 256, nnb = N / 256, ipm = nkb * nnb, total = ipm * nmat; gcount = total;
    int first = (bid - gstart) % G; if (first < 0) first += G;
    const int wave = tid >> 6, lane = tid & 63;
    for (int it = first; it < total; it += G) {
        const int mat = it / ipm, r = it % ipm, kb = r / nnb, nb = r % nnb, k0 = kb * 256, n0 = nb * 256;
        const float* W = src + (size_t)mat * sms + (size_t)k0 * N + n0; bf16* O = dst + (size_t)mat * dms;
        __syncthreads();
#pragma unroll
        for (int hp = 0; hp < 2; ++hp) { f32x4 a[8], b[8];
#pragma unroll
            for (int i = 0; i < 8; ++i) { const int k = 32 * wave + 2 * (8 * hp + i); a[i] = *(const f32x4*)(W + (size_t)k * N + 4 * lane); b[i] = *(const f32x4*)(W + (size_t)(k + 1) * N + 4 * lane); }
#pragma unroll
            for (int i = 0; i < 8; ++i) { const int k = 32 * wave + 2 * (8 * hp + i); float sa = 1.f, sb = 1.f;
                if (smode != 0) { const float ma = mu[k0 + k], mb = mu[k0 + k + 1]; sa = (smode == 1) ? 1.f - ma : ma; sb = (smode == 1) ? 1.f - mb : mb; }
                LAS unsigned char* tp = lds + (4 * lane) * 516 + k * 2;
                *(LAS unsigned*)(tp) = pkbf(a[i].x * sa, b[i].x * sb); *(LAS unsigned*)(tp + 516) = pkbf(a[i].y * sa, b[i].y * sb);
                *(LAS unsigned*)(tp + 1032) = pkbf(a[i].z * sa, b[i].z * sb); *(LAS unsigned*)(tp + 1548) = pkbf(a[i].w * sa, b[i].w * sb); } }
        __syncthreads();
#pragma unroll 4
        for (int j = 0; j < 16; ++j) { const int n = 16 * j + (tid >> 5), c = tid & 31, gn = n0 + n;
            const int row = (mode == 0) ? row_off + gn : row_off + ((gn >> 7) << 8) + (((gn >> 2) & 1) << 7) + (((gn >> 5) & 3) << 5) + (((gn >> 3) & 3) << 3) + (gn & 3);
            const LAS unsigned char* sp = lds + n * 516 + c * 16;
            v4u o; o.x = *(const LAS unsigned*)(sp); o.y = *(const LAS unsigned*)(sp + 4); o.z = *(const LAS unsigned*)(sp + 8); o.w = *(const LAS unsigned*)(sp + 12);
            *(v4u*)(O + (size_t)row * pitch + koff + k0 + 8 * c) = o; }
    }
    __syncthreads();
}

__device__ __forceinline__ void load_row(const float* src, int lane, f32x4 (&v)[4]) {
#pragma unroll
    for (int j = 0; j < 4; ++j) v[j] = *(const f32x4*)(src + 4 * lane + 256 * j);
}
__device__ __forceinline__ float row_rstd(const f32x4 (&v)[4]) {
    float s = 0.f;
#pragma unroll
    for (int j = 0; j < 4; ++j) s += (v[j].x * v[j].x + v[j].y * v[j].y) + (v[j].z * v[j].z + v[j].w * v[j].w);
    return rsqrtf(wave_sum(s) * (1.f / 1024.f) + 1e-6f);
}
__device__ __forceinline__ void modulate_row(const f32x4 (&v)[4], float rstd, const float* g, const float* shift, const float* scale, int lane, f32x4 (&h)[4]) {
#pragma unroll
    for (int j = 0; j < 4; ++j) { const int col = 4 * lane + 256 * j; const f32x4 gg = *(const f32x4*)(g + col), sh = *(const f32x4*)(shift + col), sc = *(const f32x4*)(scale + col);
        h[j] = v[j] * rstd * gg * (sc + 1.f) + sh; }
}
__device__ __forceinline__ void store_row_bf16(const f32x4 (&h)[4], bf16* dst, int lane) {
#pragma unroll
    for (int j = 0; j < 4; ++j) { v2u w; w.x = pkbf(h[j].x, h[j].y); w.y = pkbf(h[j].z, h[j].w); *(v2u*)(dst + 4 * lane + 256 * j) = w; }
}

__device__ __forceinline__ void p_norm0(const float* x, const float* ctx, const float* nw, const float* modl, bf16* H, int gw, int NGW, int lane) {
    const int per = (NTOK + NGW - 1) / NGW, r0 = gw * per, r1 = (r0 + per < NTOK) ? r0 + per : NTOK;
    f32x4 va[4], vb[4], pa[4], pb[4]; int cur_gb = -1;
#define N0_SRC(r_) ((r_) >= NLAT ? ctx + (size_t)((r_) - NLAT) * D : x + (size_t)(r_) * D)
#define N0_STEP(CUR_, r_) do { const int rw_ = (r_); if (rw_ < r1) { const bool isc = rw_ >= NLAT; const int gb = isc ? 32 : rw_ >> 11; \
        f32x4 v[4], h[4]; _Pragma("unroll") for (int j = 0; j < 4; ++j) v[j] = CUR_[j]; \
        { const int rn = rw_ + 2; if (rn < r1) load_row(N0_SRC(rn), lane, CUR_); } \
        if (gb != cur_gb) { cur_gb = gb; const float* m = modl + (size_t)gb * MODW; _Pragma("unroll") for (int j = 0; j < 4; ++j) { const int col = 4 * lane + 256 * j; pa[j] = *(const f32x4*)(nw + col) * (*(const f32x4*)(m + 1024 + col) + 1.f); pb[j] = *(const f32x4*)(m + col); } } \
        const float rstd = row_rstd(v); _Pragma("unroll") for (int j = 0; j < 4; ++j) h[j] = (v[j] * rstd) * pa[j] + pb[j]; \
        store_row_bf16(h, H + (size_t)rw_ * D, lane); } } while (0)
    if (r0 < r1) load_row(N0_SRC(r0), lane, va);
    if (r0 + 1 < r1) load_row(N0_SRC(r0 + 1), lane, vb);
#pragma unroll 1
    for (int row = r0; row < r1; row += 2) { N0_STEP(va, row); N0_STEP(vb, row + 1); }
#undef N0_STEP
#undef N0_SRC
}

typedef short bf16x8 __attribute__((ext_vector_type(8)));
typedef short short4v __attribute__((ext_vector_type(4)));
__device__ __forceinline__ void p_attn(const bf16* QKV, const float* rope, const float* sink, bf16* CAT, LAS unsigned char* lds, int bid, int G, int tid) {
    constexpr int PB = 144, TB = 64 * PB, PV = 160, BUFB = TB + 64 * PV;
    constexpr float L2E = 1.4426950408889634f, QS = 0.125f * L2E;
    const int wave = tid >> 6, lane = tid & 63, n16 = lane & 15, g = lane >> 4;
    const int skey = tid >> 3, sc = tid & 7;
    const LAS float* ropeL = (const LAS float*)(lds + 2 * BUFB);
    __syncthreads();
    for (int i = tid; i < 96 * 32; i += NTHR) ((LAS float*)(lds + 2 * BUFB))[i] = rope[i];
    __syncthreads();
    const int nxu = (G % 8 == 0) ? 2304 / 8 : 0, gpx = G / 8;
    for (int ui = 0;; ++ui) {
        int u; if (nxu) { const int w = ui * gpx + (bid >> 3); if (w >= nxu) break; u = (w < 256) ? (bid & 7) * 256 + w : 2048 + (bid & 7) * 32 + (w - 256); } else { u = ui * G + bid; if (u >= 2304) break; }
        const bool cq = u >= 2048; int b, kvh, qb;
        if (!cq) { b = u >> 6; kvh = (u >> 5) & 1; qb = u & 31; } else { const int uu = u - 2048; b = uu >> 3; kvh = (uu >> 2) & 1; qb = uu & 3; }
        const int hq = kvh * 4 + (wave & 3), sb = wave >> 2, tq0 = qb * 64 + sb * 32;
        const size_t qrow0 = (cq ? (size_t)NLAT + b * CTXL : (size_t)b * SEQ) + tq0;
        struct KSet { v4u k, p, v; bool valid, win; int tk; };
#define ATT_LOAD(t_, S_) do { const int tt_ = (t_) < ntile ? (t_) : ntile - 1; S_.win = tt_ >= 4; const int tk0_ = S_.win ? qb * 64 - 128 + (tt_ - 4) * 64 : tt_ * 64; S_.tk = tk0_ + skey; S_.valid = !S_.win || (S_.tk >= 0 && S_.tk < SEQ); \
              \
            { const int tkc_ = S_.tk < 0 ? 0 : (S_.tk >= SEQ ? SEQ - 1 : S_.tk); const size_t krow_ = S_.win ? (size_t)b * SEQ + tkc_ : (size_t)NLAT + b * CTXL + S_.tk; const bf16* kp_ = QKV + krow_ * QW + 512 + kvh * 64; \
                S_.k = *(const v4u*)(kp_ + sc * 8); S_.v = *(const v4u*)(kp_ + 128 + sc * 8); } } while (0)
        const int ntile = cq ? 4 : 9;
        KSet sA; ATT_LOAD(0, sA);
        bf16x8 qf[2][2];
#pragma unroll
        for (int qt = 0; qt < 2; ++qt)
#pragma unroll
            for (int kk = 0; kk < 2; ++kk) { const int tq = tq0 + qt * 16 + n16; const bf16* qp = QKV + (qrow0 + qt * 16 + n16) * QW + hq * 64 + kk * 32;
                float f[8]; unpack8(*(const v4u*)(qp + 8 * g), f);
                if (!cq) { float pf[8]; unpack8(*(const v4u*)(qp + 8 * (g ^ 2)), pf); const LAS float* tb = ropeL + (kk == 0 ? (tq >> 6) : 32 + (tq & 63)) * 32 + (g & 1) * 16;
#pragma unroll
                    for (int j = 0; j < 8; ++j) { const float cs = tb[2 * j], sn = tb[2 * j + 1]; f[j] = (g & 2) ? (f[j] * cs + pf[j] * sn) : (f[j] * cs - pf[j] * sn); } }
#pragma unroll
                for (int j = 0; j < 8; ++j) f[j] *= QS;
                qf[qt][kk] = __builtin_bit_cast(bf16x8, pack8(f)); }
        f32x4 ot[4][2];
#pragma unroll
        for (int dt = 0; dt < 4; ++dt) { ot[dt][0] = (f32x4){0.f, 0.f, 0.f, 0.f}; ot[dt][1] = (f32x4){0.f, 0.f, 0.f, 0.f}; }
        const float sk2 = sink[hq] * L2E;
        float m_[2] = {sk2, sk2}; f32x4 lacc[2] = {(f32x4){1.f, 1.f, 1.f, 1.f}, (f32x4){1.f, 1.f, 1.f, 1.f}};
        const bf16x8 ones8 = __builtin_bit_cast(bf16x8, (v4u){0x3f803f80u, 0x3f803f80u, 0x3f803f80u, 0x3f803f80u});
#define ATT_STORE(buf_, S_) do { LAS unsigned char* kb_ = lds + (buf_) * BUFB; v4u kw_ = (v4u){0u, 0u, 0u, 0u}; v4u vw_ = kw_; \
            asm volatile("" : "+v"(S_.k), "+v"(S_.v)); \
              \
            S_.p.x = (unsigned)__builtin_amdgcn_update_dpp(0, (int)S_.k.x, 0x4E, 0xF, 0xF, true); S_.p.y = (unsigned)__builtin_amdgcn_update_dpp(0, (int)S_.k.y, 0x4E, 0xF, 0xF, true); \
            S_.p.z = (unsigned)__builtin_amdgcn_update_dpp(0, (int)S_.k.z, 0x4E, 0xF, 0xF, true); S_.p.w = (unsigned)__builtin_amdgcn_update_dpp(0, (int)S_.k.w, 0x4E, 0xF, 0xF, true);        \
            if (S_.valid) { vw_ = S_.v; kw_ = S_.k; if (S_.win) { float kf_[8], pf_[8]; unpack8(S_.k, kf_); unpack8(S_.p, pf_); const LAS float* tb_ = ropeL + ((sc < 4) ? (S_.tk >> 6) : 32 + (S_.tk & 63)) * 32 + (sc & 1) * 16; \
                _Pragma("unroll") for (int j = 0; j < 8; ++j) { const float cs = tb_[2 * j], sn = tb_[2 * j + 1]; kf_[j] = (sc & 2) ? (kf_[j] * cs + pf_[j] * sn) : (kf_[j] * cs - pf_[j] * sn); } kw_ = pack8(kf_); } } \
            *(LAS v4u*)(kb_ + skey * PB + sc * 16) = kw_; \
            *(LAS v4u*)(kb_ + TB + skey * PV + sc * 16) = vw_; } while (0)
        auto att_qk = [&](const int buf, f32x4 (&S)[2][4]) __attribute__((always_inline)) { const LAS unsigned char* Kb = lds + buf * BUFB;
#pragma unroll
            for (int s = 0; s < 4; ++s) { const bf16x8 k0 = *(const LAS bf16x8*)(Kb + (s * 16 + n16) * PB + g * 16), k1 = *(const LAS bf16x8*)(Kb + (s * 16 + n16) * PB + 64 + g * 16);
#pragma unroll
                for (int qt = 0; qt < 2; ++qt) { const float nm = -m_[qt]; S[qt][s] = __builtin_amdgcn_mfma_f32_16x16x32_bf16(k0, qf[qt][0], (f32x4){nm, nm, nm, nm}, 0, 0, 0);
                    S[qt][s] = __builtin_amdgcn_mfma_f32_16x16x32_bf16(k1, qf[qt][1], S[qt][s], 0, 0, 0); } } };
        ATT_STORE(0, sA); ATT_LOAD(1, sA);
        __syncthreads();
#pragma unroll 1
        for (int t = 0; t < ntile; ++t) {
            const bool win = t >= 4; const int tk0 = win ? qb * 64 - 128 + (t - 4) * 64 : t * 64;
            const LAS unsigned char* Vb = lds + (t & 1) * BUFB + TB + (4 * g + (n16 >> 2)) * PV + (n16 & 3) * 8;
            f32x4 st[2][4];
            att_qk(t & 1, st);
            if (win && (tk0 < tq0 - 97 || tk0 + 63 > tq0 + 128 || tk0 < 0 || tk0 + 63 >= SEQ)) {
#pragma unroll
                for (int qt = 0; qt < 2; ++qt) { const int tq = tq0 + qt * 16 + n16;
#pragma unroll
                    for (int s = 0; s < 4; ++s)
#pragma unroll
                        for (int j = 0; j < 4; ++j) { const int tk = tk0 + s * 16 + 4 * g + j, dl = tk - tq; const bool ok = (tk >= 0) && (tk < SEQ) && (dl <= 128) && (dl >= -128); st[qt][s][j] = ok ? st[qt][s][j] : -1e30f; } }
            }
            bf16x8 pfr[2][2];
#pragma unroll
            for (int qt = 0; qt < 2; ++qt) {
                f32x4 d[4];
#pragma unroll
                for (int s = 0; s < 4; ++s) d[s] = st[qt][s];
                float mx = fmaxf(fmaxf(d[0][0], d[0][1]), fmaxf(d[0][2], d[0][3]));
#pragma unroll
                for (int s = 1; s < 4; ++s) mx = fmaxf(mx, fmaxf(fmaxf(d[s][0], d[s][1]), fmaxf(d[s][2], d[s][3])));
                if (__any(mx > 8.f)) {
                    float gm = fmaxf(mx, __shfl_xor(mx, 16)); gm = fmaxf(gm, __shfl_xor(gm, 32)); gm = fmaxf(gm, 0.f);
                    const float corr = __builtin_amdgcn_exp2f(-gm); m_[qt] += gm; lacc[qt] *= corr;
#pragma unroll
                    for (int s = 0; s < 4; ++s) d[s] -= gm;
#pragma unroll
                    for (int dt = 0; dt < 4; ++dt) ot[dt][qt] *= corr; }
                float pe[4][4];
#pragma unroll
                for (int s = 0; s < 4; ++s)
#pragma unroll
                    for (int j = 0; j < 4; ++j) pe[s][j] = __builtin_amdgcn_exp2f(d[s][j]);
#pragma unroll
                for (int pr = 0; pr < 2; ++pr) { v4u w; w.x = pkbf(pe[2 * pr][0], pe[2 * pr][1]); w.y = pkbf(pe[2 * pr][2], pe[2 * pr][3]); w.z = pkbf(pe[2 * pr + 1][0], pe[2 * pr + 1][1]); w.w = pkbf(pe[2 * pr + 1][2], pe[2 * pr + 1][3]);
                    pfr[qt][pr] = __builtin_bit_cast(bf16x8, w); }
            }
#pragma unroll
            for (int dt = 0; dt < 4; ++dt)
#pragma unroll
                for (int pr = 0; pr < 2; ++pr) {
                    const short4v v0 = __builtin_amdgcn_ds_read_tr16_b64_v4i16((LAS short4v*)(Vb + pr * 32 * PV + dt * 32)), v1 = __builtin_amdgcn_ds_read_tr16_b64_v4i16((LAS short4v*)(Vb + pr * 32 * PV + 16 * PV + dt * 32));
                    const bf16x8 vf = __builtin_shufflevector(v0, v1, 0, 1, 2, 3, 4, 5, 6, 7);
                    ot[dt][0] = __builtin_amdgcn_mfma_f32_16x16x32_bf16(vf, pfr[0][pr], ot[dt][0], 0, 0, 0); ot[dt][1] = __builtin_amdgcn_mfma_f32_16x16x32_bf16(vf, pfr[1][pr], ot[dt][1], 0, 0, 0); }
#pragma unroll
            for (int pr = 0; pr < 2; ++pr) { lacc[0] = __builtin_amdgcn_mfma_f32_16x16x32_bf16(ones8, pfr[0][pr], lacc[0], 0, 0, 0); lacc[1] = __builtin_amdgcn_mfma_f32_16x16x32_bf16(ones8, pfr[1][pr], lacc[1], 0, 0, 0); }
            ATT_STORE((t + 1) & 1, sA);
            ATT_LOAD(t + 2, sA);
            asm volatile("s_waitcnt lgkmcnt(0)" ::: "memory"); __builtin_amdgcn_s_barrier(); asm volatile("" ::: "memory");
        }
#undef ATT_LOAD
#undef ATT_STORE
#pragma unroll
        for (int qt = 0; qt < 2; ++qt) { const float inv = 1.f / lacc[qt][0];
            bf16* op = CAT + (qrow0 + qt * 16 + n16) * D + hq * 64 + 4 * g;
#pragma unroll
            for (int dt = 0; dt < 4; ++dt) { v2u w; w.x = pkbf(ot[dt][qt][0] * inv, ot[dt][qt][1] * inv); w.y = pkbf(ot[dt][qt][2] * inv, ot[dt][qt][3] * inv); *(v2u*)(op + dt * 16) = w; } }
    }
}

template <int CTRL> __device__ __forceinline__ float dppz(float v) { return __builtin_bit_cast(float, __builtin_amdgcn_update_dpp(0, __builtin_bit_cast(int, v), CTRL, 0xF, 0xF, true)); }
template <int CTRL> __device__ __forceinline__ float dpp_old(float old, float v) { return __builtin_bit_cast(float, __builtin_amdgcn_update_dpp(__builtin_bit_cast(int, old), __builtin_bit_cast(int, v), CTRL, 0xF, 0xF, false)); }
__device__ __forceinline__ float tanh_fast(float x) { return 1.f - 2.f * __builtin_amdgcn_rcpf(1.f + __expf(2.f * x)); }
__device__ __forceinline__ float gelu_fast(float x) { return 0.5f * x * (1.f + tanh_fast(0.7978845608028654f * (x + 0.044715f * x * x * x))); }
__device__ __forceinline__ void p_lru(const bf16* QKV, const float* conv_w, const float* conv_b, const float* wa, const float* ba, const float* wi, const float* bi, const float* lam,
                                      float* YB, bf16* CAT, LAS unsigned char* lds, int bid, int G, int tid, int variant = 0) {
    constexpr int TP = 144, TILE = 16 * TP;
    const int wave = tid >> 6, lane = tid & 63, n16 = lane & 15, g = lane >> 4, dir = wave & 1, mt = wave >> 1;
    const int tl = dir ? 15 - n16 : n16;
    const int s_tile = tid >> 8, s_tok = (tid >> 4) & 15, s_c4 = (tid & 15) * 4;
    const f32x4 zero4 = (f32x4){0.f, 0.f, 0.f, 0.f};
    for (int u = bid; u < 256; u += G) {
        const int b = u >> 3, cb = u & 7;
        bf16x8 waf[2], wif[2];
#pragma unroll
        for (int kk = 0; kk < 2; ++kk) { float fa[8], fi[8];
#pragma unroll
            for (int i = 0; i < 8; ++i) { const size_t o = ((size_t)(dir * 8 + cb) * 64 + 32 * kk + 8 * g + i) * 64 + 16 * mt + n16; fa[i] = wa[o]; fi[i] = wi[o]; }
            waf[kk] = __builtin_bit_cast(bf16x8, pack8(fa)); wif[kk] = __builtin_bit_cast(bf16x8, pack8(fi)); }
        float gba[4], gbi[4], sp8[4], hin[4];
#pragma unroll
        for (int j = 0; j < 4; ++j) { const int c = dir * 512 + cb * 64 + 16 * mt + 4 * g + j; gba[j] = ba[c]; gbi[j] = bi[c]; sp8[j] = 8.f * 1.4426950408889634f * softplusf_(-lam[c]); hin[j] = 0.f; }
        float cw[4][4], cbias[4];
#pragma unroll
        for (int i = 0; i < 4; ++i) { cbias[i] = conv_b[cb * 64 + s_c4 + i];
#pragma unroll
            for (int j = 0; j < 4; ++j) cw[j][i] = conv_w[j * 512 + cb * 64 + s_c4 + i]; }
        v2u tp0[4], tp1[4], tp2[4], tp3[4]; f32x4 o0 = zero4, o1 = zero4, o2 = zero4, o3 = zero4; v2u g0 = (v2u){0u, 0u}, g1 = g0, g2 = g0, g3 = g0;
#define LRU_TAPS(kn_, tp_) do { const int kn = (kn_); const bool isc_ = kn < 16; const int gi_ = isc_ ? (s_tile ? 15 - kn : kn) : (s_tile ? 143 - kn : kn - 16); \
            const int t_ = gi_ * 16 + s_tok, len_ = isc_ ? CTXL : SEQ; const int rb_ = isc_ ? NLAT + b * CTXL : b * SEQ;        \
            _Pragma("unroll") for (int j = 0; j < 4; ++j) { const int ts = t_ - 2 + j; tp_[j] = (ts >= 0 && ts < len_) ? *(const v2u*)((const char*)QKV + ((unsigned)(rb_ + ts) * (unsigned)(QW * 2) + (unsigned)((768 + cb * 64 + s_c4) * 2))) : (v2u){0u, 0u}; } } while (0)
#define LRU_CONV(kn_, tp_) do { float a_[4] = {cbias[0], cbias[1], cbias[2], cbias[3]}; \
            _Pragma("unroll") for (int j = 0; j < 4; ++j) { a_[0] += bflo(tp_[j].x) * cw[j][0]; a_[1] += bfhi(tp_[j].x) * cw[j][1]; a_[2] += bflo(tp_[j].y) * cw[j][2]; a_[3] += bfhi(tp_[j].y) * cw[j][3]; } \
            v2u w_; w_.x = pkbf(a_[0], a_[1]); w_.y = pkbf(a_[2], a_[3]); *(LAS v2u*)(lds + (((kn_) & 1) * 2 + s_tile) * TILE + s_tok * TP + s_c4 * 2) = w_; } while (0)
#define LRU_ROW(k_, out_) do { const int kq = (k_); const bool isc_ = kq < 16; const int gi_ = isc_ ? (dir ? 15 - kq : kq) : (dir ? 143 - kq : kq - 16); out_ = (isc_ ? NLAT + b * CTXL : b * SEQ) + gi_ * 16 + tl; } while (0)
#define LRU_FIN(k_) (((k_) < 16) ? ((k_) >= 8) : ((k_) >= 80))
#define LRU_OG(kq_, o_, g_) do { int rn_; LRU_ROW(kq_, rn_); o_ = *(const f32x4*)((const char*)YB + ((unsigned)((1 - dir) * NTOK + rn_) * 2048u + (unsigned)(cc * 4))); g_ = *(const v2u*)((const char*)QKV + ((unsigned)rn_ * (unsigned)(QW * 2) + (unsigned)((1280 + cc) * 2))); } while (0)
        const int cc = cb * 64 + 16 * mt + 4 * g;
        const float oob[4] = {n16 < 1 ? 1.f : 0.f, n16 < 2 ? 1.f : 0.f, n16 < 4 ? 1.f : 0.f, n16 < 8 ? 1.f : 0.f};
        __syncthreads();
        LRU_TAPS(0, tp0); LRU_CONV(0, tp0); LRU_TAPS(1, tp1); LRU_TAPS(2, tp2); LRU_TAPS(3, tp3);
        __syncthreads();
#define LRU_STEP(k_, oU, gU, oL, gL, tC, tL) do { const int k = (k_); if (variant != 1) { \
            if (k == 8 || k == 80) { LRU_OG(k, oU, gU);   } \
            { const int kn = k + 3; if (kn < 144 && LRU_FIN(kn) && (kn < 16 ? k >= 8 : k >= 80)) LRU_OG(kn, oL, gL); } \
            if (k == 8 || k == 80) { if (LRU_FIN(k + 1)) LRU_OG(k + 1, o_x1, g_x1); if (LRU_FIN(k + 2)) LRU_OG(k + 2, o_x2, g_x2); } \
            int row; LRU_ROW(k, row); const bool fin = LRU_FIN(k); \
            if (k + 1 < 144) { LRU_CONV(k + 1, tC); if (k + 4 < 144) LRU_TAPS(k + 4, tL); } \
            { const LAS unsigned char* ut = lds + ((k & 1) * 2 + dir) * TILE + tl * TP; \
              const bf16x8 uf0 = *(const LAS bf16x8*)(ut + g * 16), uf1 = *(const LAS bf16x8*)(ut + 64 + g * 16); \
              f32x4 pr = __builtin_amdgcn_mfma_f32_16x16x32_bf16(waf[0], uf0, zero4, 0, 0, 0); pr = __builtin_amdgcn_mfma_f32_16x16x32_bf16(waf[1], uf1, pr, 0, 0, 0); \
              f32x4 pi = __builtin_amdgcn_mfma_f32_16x16x32_bf16(wif[0], uf0, zero4, 0, 0, 0); pi = __builtin_amdgcn_mfma_f32_16x16x32_bf16(wif[1], uf1, pi, 0, 0, 0); \
              const v2u up = *(const LAS v2u*)(ut + (16 * mt + 4 * g) * 2); \
              const float uu[4] = {bflo(up.x), bfhi(up.x), bflo(up.y), bfhi(up.y)}; \
              float h[4]; \
              _Pragma("unroll") for (int j = 0; j < 4; ++j) { \
                  const float r = sigmoid_fast(pr[j] + gba[j]), ig = sigmoid_fast(pi[j] + gbi[j]); \
                  float A = __builtin_amdgcn_exp2f(-r * sp8[j]); float B = __builtin_amdgcn_sqrtf(fmaxf(1.f - A * A, 0.f)) * ig * uu[j]; \
                    \
                  { const float Ap = dppz<0x111>(A) + oob[0], Bp = dppz<0x111>(B); B = A * Bp + B; A = A * Ap; } \
                  { const float Ap = dppz<0x112>(A) + oob[1], Bp = dppz<0x112>(B); B = A * Bp + B; A = A * Ap; } \
                  { const float Ap = dppz<0x114>(A) + oob[2], Bp = dppz<0x114>(B); B = A * Bp + B; A = A * Ap; } \
                  { const float Ap = dppz<0x118>(A) + oob[3], Bp = dppz<0x118>(B); B = A * Bp + B; A = A * Ap; } \
                  h[j] = A * hin[j] + B; hin[j] = __shfl(h[j], (lane & 48) | 15); } \
              if (!fin) *(f32x4*)((char*)YB + ((unsigned)(dir * NTOK + row) * 2048u + (unsigned)(cc * 4))) = (f32x4){h[0], h[1], h[2], h[3]}; \
              else { v2u w; w.x = pkbf((h[0] + oU.x) * gelu_fast(bflo(gU.x)), (h[1] + oU.y) * gelu_fast(bfhi(gU.x))); w.y = pkbf((h[2] + oU.z) * gelu_fast(bflo(gU.y)), (h[3] + oU.w) * gelu_fast(bfhi(gU.y))); \
                  *(v2u*)((char*)CAT + ((unsigned)row * (unsigned)(D * 2) + (unsigned)((512 + cc) * 2))) = w; } } } \
            if (k == 7 || k == 79) __syncthreads();        \
            else { asm volatile("s_waitcnt lgkmcnt(0)" ::: "memory"); __builtin_amdgcn_s_barrier(); asm volatile("" ::: "memory"); }        \
        } while (0)
#pragma unroll 1
        for (int k4 = 0; k4 < 144; k4 += 4) {
#define o_x1 o1
#define g_x1 g1
#define o_x2 o2
#define g_x2 g2
            LRU_STEP(k4 + 0, o0, g0, o3, g3, tp1, tp0);
            LRU_STEP(k4 + 1, o1, g1, o0, g0, tp2, tp1);
            LRU_STEP(k4 + 2, o2, g2, o1, g1, tp3, tp2);
            LRU_STEP(k4 + 3, o3, g3, o2, g2, tp0, tp3);
#undef o_x1
#undef g_x1
#undef o_x2
#undef g_x2
        }
#undef LRU_STEP
#undef LRU_OG
#undef LRU_TAPS
#undef LRU_CONV
#undef LRU_ROW
#undef LRU_FIN
    }
}
__device__ __forceinline__ void p_norm_router(const bf16* XL, const bf16* XC, int nrows, const float* nw, const float* modl, const float* rw, bf16* H2, float* affl, float* affc,
                                              LAS unsigned char* lds, int bid, int G, int tid) {
    LAS unsigned short* WH = (LAS unsigned short*)lds;
    LAS unsigned short* WL = WH + 16 * 1032;
    __syncthreads();
    { f32x4 wv[8];
#pragma unroll
      for (int q = 0; q < 8; ++q) wv[q] = *(const f32x4*)(rw + (size_t)(q * NTHR + tid) * 4);
#pragma unroll
      for (int q = 0; q < 8; ++q) { const int i4 = q * NTHR + tid, col = i4 >> 2, e0 = (i4 & 3) * 4;
#pragma unroll
          for (int j = 0; j < 4; ++j) { const float w = wv[q][j]; const unsigned hi = pkbf(w, 0.f) & 0xffffu; const float lo = w - __uint_as_float(hi << 16);
              WH[(e0 + j) * 1032 + col] = (unsigned short)hi; WL[(e0 + j) * 1032 + col] = (unsigned short)(pkbf(lo, 0.f) & 0xffffu); } } }
    __syncthreads();
    const int wave = tid >> 6, lane = tid & 63, n16 = lane & 15, g = lane >> 4, gw = bid * NWAVES + wave, NGW = G * NWAVES;
    const int ngroups = nrows >> 4;
    LAS float* PA = (LAS float*)(lds + 2 * 16 * 1032 * 2 + wave * 8192);
#define RT_SRC(grp_) ((grp_) * 16 + n16 >= NLAT ? XC + (size_t)((grp_) * 16 + n16 - NLAT) * D : XL + (size_t)((grp_) * 16 + n16) * 2048)
    float ss_next = 0.f;
    if (gw < ngroups) { const bf16* s0 = RT_SRC(gw);
#pragma unroll 16
        for (int kk = 0; kk < 32; ++kk) { float a[8]; unpack8(*(const v4u*)(s0 + 32 * kk + 8 * g), a);
            ss_next += (a[0] * a[0] + a[1] * a[1]) + (a[2] * a[2] + a[3] * a[3]) + (a[4] * a[4] + a[5] * a[5]) + (a[6] * a[6] + a[7] * a[7]); } }
    for (int grp = gw; grp < ngroups; grp += NGW) {
        const int row = grp * 16 + n16; const bool isc = row >= NLAT; const bf16* src = RT_SRC(grp); const int gb = isc ? 32 : row >> 11;
        const bf16* srcn = (grp + NGW < ngroups) ? RT_SRC(grp + NGW) : src;
        const float* m = modl + (size_t)gb * MODW; bf16* hrow = H2 + (size_t)row * D;
#pragma unroll
        for (int i = 0; i < 4; ++i) { const int c = (i * 64 + lane) * 4; const f32x4 gg = *(const f32x4*)(nw + c), sh = *(const f32x4*)(m + 3 * 1024 + c), sc = *(const f32x4*)(m + 4 * 1024 + c);
            *(LAS f32x4*)(PA + c) = gg * (sc + 1.f); *(LAS f32x4*)(PA + 1024 + c) = sh; }
        float ss = ss_next + 0.f; ss_next = 0.f;
        ss = rows_sum(ss);
        const float rstd = rsqrtf(ss * (1.f / 1024.f) + 1e-6f);
        f32x4 acc = (f32x4){0.f, 0.f, 0.f, 0.f};
        v4u bxa[4], bna[4], bxb[4], bnb[4];
#define RT_LD(X_, N_, bt_) do { const int bb_ = (bt_) < 8 ? (bt_) : 7; _Pragma("unroll") for (int i = 0; i < 4; ++i) { const int c0 = 32 * (4 * bb_ + i) + 8 * g; X_[i] = *(const v4u*)(src + c0); N_[i] = *(const v4u*)(srcn + c0); } } while (0)
#define RT_PROC(X_, N_, bt_) do { _Pragma("unroll") for (int i4 = 0; i4 < 4; ++i4) { const int kk = 4 * (bt_) + i4; const int c0 = 32 * kk + 8 * g; float x[8], h[8], lo[8]; \
            unpack8(X_[i4], x);        \
            { float a[8]; unpack8(N_[i4], a); ss_next += (a[0] * a[0] + a[1] * a[1]) + (a[2] * a[2] + a[3] * a[3]) + (a[4] * a[4] + a[5] * a[5]) + (a[6] * a[6] + a[7] * a[7]); } \
            _Pragma("unroll") for (int hf = 0; hf < 2; ++hf) { const f32x4 aa = *(const LAS f32x4*)(PA + c0 + 4 * hf), sh = *(const LAS f32x4*)(PA + 1024 + c0 + 4 * hf); \
                _Pragma("unroll") for (int i = 0; i < 4; ++i) h[4 * hf + i] = (x[4 * hf + i] * rstd) * aa[i] + sh[i]; } \
            const v4u hp = pack8(h); *(v4u*)(hrow + c0) = hp; \
            { float hh[8]; unpack8(hp, hh); \
              _Pragma("unroll") for (int i = 0; i < 8; ++i) lo[i] = h[i] - hh[i]; } \
            const bf16x8 ah = __builtin_bit_cast(bf16x8, hp), al = __builtin_bit_cast(bf16x8, pack8(lo)); \
            const bf16x8 bh = *(const LAS bf16x8*)(WH + n16 * 1032 + c0), bl = *(const LAS bf16x8*)(WL + n16 * 1032 + c0); \
            acc = __builtin_amdgcn_mfma_f32_16x16x32_bf16(ah, bh, acc, 0, 0, 0); acc = __builtin_amdgcn_mfma_f32_16x16x32_bf16(ah, bl, acc, 0, 0, 0); acc = __builtin_amdgcn_mfma_f32_16x16x32_bf16(al, bh, acc, 0, 0, 0); } } while (0)
        RT_LD(bxa, bna, 0);
#pragma unroll 1
        for (int b2 = 0; b2 < 8; b2 += 2) { RT_LD(bxb, bnb, b2 + 1); RT_PROC(bxa, bna, b2); RT_LD(bxa, bna, b2 + 2); RT_PROC(bxb, bnb, b2 + 1); }
#undef RT_PROC
#undef RT_LD
#pragma unroll
        for (int j = 0; j < 4; ++j) { float v = acc[j]; float mx = v;
            mx = fmaxf(mx, dppmov<0xB1>(mx)); mx = fmaxf(mx, dppmov<0x4E>(mx)); mx = fmaxf(mx, dppmov<0x141>(mx)); mx = fmaxf(mx, dppmov<0x140>(mx));
            const float ex = expf(v - mx); float sm = ex; sm += dppmov<0xB1>(sm); sm += dppmov<0x4E>(sm); sm += dppmov<0x141>(sm); sm += dppmov<0x140>(sm);
            const float aff = ex / sm; const int r = grp * 16 + 4 * g + j;
            if (r < NLAT) affl[((size_t)(r >> 11) * 16 + n16) * SEQ + (r & 2047)] = aff; else { const int rc = r - NLAT; affc[((size_t)(rc >> 8) * 16 + n16) * CTXL + (rc & 255)] = aff; } }
    }
#undef RT_SRC
}
template <int J>
__device__ __forceinline__ void topk_unit(const float* vals, int cap, int row0, int Rbase, int e, int* stok, float* sgate, short* inv, int lane) {
    unsigned vb[J];
#pragma unroll
    for (int j = 0; j < J; ++j) vb[j] = __float_as_uint(vals[j * 64 + lane]);
    unsigned T = 0u;
    for (int bit = 31; bit >= 0; --bit) { const unsigned cand = T | (1u << bit); int c = 0;
#pragma unroll
        for (int j = 0; j < J; ++j) c += (vb[j] >= cand) ? 1 : 0;
        c = wave_sum_i(c);
        if (c >= cap) T = cand; }
    int ngt = 0;
#pragma unroll
    for (int j = 0; j < J; ++j) ngt += (vb[j] > T) ? 1 : 0;
    ngt = wave_sum_i(ngt);
    const int need_eq = cap - ngt;
    const unsigned long long lt = (lane == 0) ? 0ull : (~0ull >> (64 - lane));
    int base = 0, eqseen = 0;
#pragma unroll
    for (int j = 0; j < J; ++j) {
        const bool gt = vb[j] > T, eq = vb[j] == T;
        const unsigned long long meq = __ballot(eq); const int eqrank = eqseen + __popcll(meq & lt);
        const bool sel = gt || (eq && eqrank < need_eq);
        const unsigned long long msel = __ballot(sel); const int slot = base + __popcll(msel & lt);
        const int row = row0 + j * 64 + lane;
        if (sel) { const int R = Rbase + slot; stok[R] = row; sgate[R] = __uint_as_float(vb[j]); inv[(size_t)row * 16 + e] = (short)slot; }
        else inv[(size_t)row * 16 + e] = (short)-1;
        base += __popcll(msel); eqseen += __popcll(meq);
    }
}
__device__ __forceinline__ void p_topk(const float* affl, const float* affc, int nunits, int rpe, int* stok, float* sgate, short* inv, int gw, int NGW, int lane) {
    for (int u = gw; u < nunits; u += NGW) {
        const bool isc = u >= 512; const int uu = u & 511, b = uu >> 4, e = uu & 15;
        if (!isc) topk_unit<32>(affl + (size_t)(b * 16 + e) * SEQ, SEQ >> 3, b * SEQ, e * rpe + b * 256, e, stok, sgate, inv, lane);
        else topk_unit<4>(affc + (size_t)(b * 16 + e) * CTXL, CTXL >> 3, NLAT + b * CTXL, e * rpe + 8192 + b * 32, e, stok, sgate, inv, lane);
    }
}
__device__ __forceinline__ void p_gather(const bf16* H2, const int* stok, int nslots, bf16* XIN, int gw, int NGW, int lane) {
    for (int R = gw; R < nslots; R += NGW) { const int row = stok[R]; const v4u* s = (const v4u*)(H2 + (size_t)row * D); v4u* d = (v4u*)(XIN + (size_t)R * D); d[lane] = s[lane]; d[64 + lane] = s[64 + lane]; }
}
template <int MODE>
__device__ __forceinline__ void p_combine(bf16* XL, bf16* XC, int nrows, const bf16* Y, const float* sgate, const short* inv, int rpe, const float* modl, const float* modn, const float* nw, bf16* HN, int gw, int NGW, int lane) {
    const int per = (nrows + NGW - 1) / NGW, r0 = gw * per, r1 = (r0 + per < nrows) ? r0 + per : nrows;
    v2u xn[2][4]; int sn[2] = {-1, -1};
    f32x4 pg[4], pa[4], pb[4]; int cur_gb = -1;
#define CMB_XP(r_) ((r_) >= NLAT ? XC + (size_t)((r_) - NLAT) * D : XL + (size_t)(r_) * 2048)
#define CMB_PRE(k_, r_) do { const int rr_ = (r_); if (rr_ < r1) { const bf16* xp_ = CMB_XP(rr_); _Pragma("unroll") for (int j = 0; j < 4; ++j) xn[k_][j] = *(const v2u*)(xp_ + 4 * lane + 256 * j); \
        sn[k_] = (int)inv[(size_t)rr_ * 16 + (lane & 15)]; } } while (0)
    CMB_PRE(0, r0); CMB_PRE(1, r0 + 1);
    for (int row0 = r0; row0 < r1; row0 += 2) {
        constexpr int NS = 4;
        f32x4 acc[2][4], x[2][4]; bool ok[2]; int offs[2], sv[2]; v2u raw[2][NS][4]; float gsl[2][NS]; int cnt[2]; unsigned rest[2];
#pragma unroll
        for (int k = 0; k < 2; ++k) { const int row = row0 + k; ok[k] = row < r1; const bool isc = row >= NLAT; offs[k] = isc ? 8192 + ((row - NLAT) >> 8) * 32 : (row >> 11) * 256;
#pragma unroll
            for (int j = 0; j < 4; ++j) { acc[k][j] = (f32x4){0.f, 0.f, 0.f, 0.f}; x[k][j] = (f32x4){bflo(xn[k][j].x), bfhi(xn[k][j].x), bflo(xn[k][j].y), bfhi(xn[k][j].y)}; }
            sv[k] = sn[k]; }
        CMB_PRE(0, row0 + 2); CMB_PRE(1, row0 + 3);
#pragma unroll
        for (int k = 0; k < 2; ++k) { unsigned mm = ok[k] ? (unsigned)(__ballot(sv[k] >= 0) & 0xffffull) : 0u; cnt[k] = __builtin_popcount(mm) < NS ? __builtin_popcount(mm) : NS;
            const bf16* yr = Y + 4 * lane; int Rr = 0;
#pragma unroll
            for (int j = 0; j < NS; ++j) { if (mm) { const int e = __builtin_ctz(mm); mm &= mm - 1u; const int sl = __builtin_amdgcn_readlane(sv[k], e); Rr = e * rpe + offs[k] + sl; yr = Y + (size_t)Rr * D + 4 * lane; }
                { int rv = Rr; asm volatile("" : "+v"(rv)); gsl[k][j] = sgate[rv]; }
#pragma unroll
                for (int q = 0; q < 4; ++q) raw[k][j][q] = *(const v2u*)(yr + 256 * q); }
            rest[k] = mm; }
#pragma unroll
        for (int k = 0; k < 2; ++k) {
#pragma unroll
            for (int j = 0; j < NS; ++j) if (j < cnt[k]) { const float gs = gsl[k][j];
#pragma unroll
                for (int q = 0; q < 4; ++q) { const v2u p = raw[k][j][q]; acc[k][q].x += gs * bflo(p.x); acc[k][q].y += gs * bfhi(p.x); acc[k][q].z += gs * bflo(p.y); acc[k][q].w += gs * bfhi(p.y); } }
            unsigned mm = rest[k];
            while (mm) { const int e = __builtin_ctz(mm); mm &= mm - 1u; const int sl = __builtin_amdgcn_readlane(sv[k], e); const int Rt = e * rpe + offs[k] + sl; const bf16* yr = Y + (size_t)Rt * D + 4 * lane;
                int rv = Rt; asm volatile("" : "+v"(rv)); const float gs = sgate[rv];
#pragma unroll
                for (int q = 0; q < 4; ++q) { const v2u p = *(const v2u*)(yr + 256 * q); acc[k][q].x += gs * bflo(p.x); acc[k][q].y += gs * bfhi(p.x); acc[k][q].z += gs * bflo(p.y); acc[k][q].w += gs * bfhi(p.y); } } }
#pragma unroll
        for (int k = 0; k < 2; ++k) { const int row = row0 + k; if (!ok[k]) continue;
            const bool isc = row >= NLAT; bf16* xr = isc ? XC + (size_t)(row - NLAT) * D : XL + (size_t)row * 2048; const int gb = isc ? 32 : row >> 11;
            if (gb != cur_gb) { cur_gb = gb; const float* m5 = modl + (size_t)gb * MODW + 5 * 1024; const float* mn = modn + (size_t)gb * MODW;
#pragma unroll
                for (int j = 0; j < 4; ++j) { const int col = 4 * lane + 256 * j; pg[j] = *(const f32x4*)(m5 + col);
                    if (MODE == 0) { pa[j] = *(const f32x4*)(nw + col) * (*(const f32x4*)(mn + 1024 + col) + 1.f); pb[j] = *(const f32x4*)(mn + col); } else pa[j] = *(const f32x4*)(nw + col); } }
#pragma unroll
            for (int j = 0; j < 4; ++j) x[k][j] = x[k][j] + pg[j] * acc[k][j];
            if (MODE == 0) {
                f32x4 xq[4];
#pragma unroll
                for (int j = 0; j < 4; ++j) { v2u w; w.x = pkbf(x[k][j].x, x[k][j].y); w.y = pkbf(x[k][j].z, x[k][j].w); *(v2u*)(xr + 4 * lane + 256 * j) = w; xq[j] = (f32x4){bflo(w.x), bfhi(w.x), bflo(w.y), bfhi(w.y)}; }
                const float rstd = row_rstd(xq); f32x4 h[4];
#pragma unroll
                for (int j = 0; j < 4; ++j) h[j] = (xq[j] * rstd) * pa[j] + pb[j];
                store_row_bf16(h, HN + (size_t)row * 2048, lane);
            } else {
                const float rstd = row_rstd(x[k]); float* orow = (float*)XL + (size_t)row * D;
#pragma unroll
                for (int j = 0; j < 4; ++j) *(f32x4*)(orow + 4 * lane + 256 * j) = x[k][j] * rstd * pa[j];
            } }
    }
#undef CMB_PRE
#undef CMB_XP
}
__device__ __forceinline__ void p_shift(bf16* HN, const float* mu, bf16* XR, int xr_pitch, bf16* XK, bf16* XV, int gw, int NGW, int lane) {
    const int per = (NTOK + NGW - 1) / NGW, r0 = gw * per, r1 = (r0 + per < NTOK) ? r0 + per : NTOK;
    if (r0 >= r1) return;
    float mr[16], mk[16], mv[16];
#pragma unroll
    for (int qh = 0; qh < 2; ++qh)
#pragma unroll
        for (int hf = 0; hf < 2; ++hf) { const int c = qh * 512 + 8 * lane + 4 * hf; const f32x4 a = *(const f32x4*)(mu + c), k = *(const f32x4*)(mu + 2 * 1024 + c), v = *(const f32x4*)(mu + 3 * 1024 + c);
#pragma unroll
            for (int i = 0; i < 4; ++i) { mr[8 * qh + 4 * hf + i] = a[i]; mk[8 * qh + 4 * hf + i] = k[i]; mv[8 * qh + 4 * hf + i] = v[i]; } }
    struct RowSet { v4u q[2]; };
#define SH_LOAD(S_, r_) do { int rr_ = (r_); rr_ = rr_ < 0 ? 0 : (rr_ >= NTOK ? NTOK - 1 : rr_); S_.q[0] = *(const v4u*)(HN + (size_t)rr_ * 2048 + 8 * lane); S_.q[1] = *(const v4u*)(HN + (size_t)rr_ * 2048 + 512 + 8 * lane); } while (0)
#define SH_STEP(P_, C_, N_, L_, r_) do { const int row = (r_); if (row < r1) { SH_LOAD(L_, row + 2); \
        const bool isc = row >= NLAT; const int t = isc ? (row - NLAT) & 255 : row & 2047, len = isc ? CTXL : SEQ; const bool hp = t > 0, hn = t < len - 1; \
        _Pragma("unroll") for (int qh = 0; qh < 2; ++qh) { float a[8], c[8], h[8]; unpack8(P_.q[qh], a); unpack8(N_.q[qh], c); unpack8(C_.q[qh], h); \
            _Pragma("unroll") for (int i = 0; i < 8; ++i) a[i] = 0.5f * ((hp ? a[i] : 0.f) + (hn ? c[i] : 0.f)); \
            *(v4u*)(HN + (size_t)row * 2048 + 1024 + qh * 512 + 8 * lane) = pack8(a); \
            _Pragma("unroll") for (int i = 0; i < 8; ++i) { a[i] -= h[i]; c[i] = h[i] + mk[8 * qh + i] * a[i]; } \
            *(v4u*)(XK + (size_t)row * D + qh * 512 + 8 * lane) = pack8(c); \
            _Pragma("unroll") for (int i = 0; i < 8; ++i) c[i] = h[i] + mv[8 * qh + i] * a[i]; \
            *(v4u*)(XV + (size_t)row * D + qh * 512 + 8 * lane) = pack8(c); \
            if (!isc) { \
                _Pragma("unroll") for (int i = 0; i < 8; ++i) c[i] = h[i] + mr[8 * qh + i] * a[i]; \
                *(v4u*)(XR + (size_t)row * xr_pitch + qh * 512 + 8 * lane) = pack8(c); } } } } while (0)
    RowSet sa, sb, sc, sd; SH_LOAD(sa, r0 - 1); SH_LOAD(sb, r0); SH_LOAD(sc, r0 + 1);
#pragma unroll 1
    for (int r = r0; r < r1; r += 4) { SH_STEP(sa, sb, sc, sd, r); SH_STEP(sb, sc, sd, sa, r + 1); SH_STEP(sc, sd, sa, sb, r + 2); SH_STEP(sd, sa, sb, sc, r + 3); }
#undef SH_STEP
#undef SH_LOAD
}
__device__ __forceinline__ bf16x8 mk8(v2u a, v2u b) { v4u w; w.x = a.x; w.y = a.y; w.z = b.x; w.w = b.y; return __builtin_bit_cast(bf16x8, w); }
__device__ __forceinline__ v2u pk4(f32x4 v) { v2u w; w.x = pkbf(v.x, v.y); w.y = pkbf(v.z, v.w); return w; }
#define MFMA16(a, b, c) __builtin_amdgcn_mfma_f32_16x16x32_bf16((a), (b), (c), 0, 0, 0)
__device__ __forceinline__ void p_wkv(const bf16* R, const bf16* K, const bf16* V, const bf16* L, const float* w0, const float* w2, const float* a0, const float* a2,
                                      const float* kkw, const float* kaw, const float* rkw, bf16* Y, size_t yds, float* COEF, LAS unsigned char* lds, int bid, int G, int tid, int variant = 0) {
    constexpr int CHB = 11776, O_BH = 0, O_KH = 2304, O_AT = 4608, O_RT = 6912, O_V = 9216, O_WC = 11520, O_NS = 8 * CHB, O_CST = O_NS + 4096, O_W2 = O_CST + 1280, O_A2 = O_W2 + 8192;
#ifdef PROBE_ROLE_PARITY
    const int wave = tid >> 6, lane = tid & 63, role = wave & 1, q = wave >> 1;
#else
    const int wave = tid >> 6, lane = tid & 63, role = wave >> 2, q = wave & 3;
#endif
    LAS float* CST = (LAS float*)(lds + O_CST);
    LAS float* NS = (LAS float*)(lds + O_NS + q * 1024);
    const f32x4 zero4 = (f32x4){0.f, 0.f, 0.f, 0.f}; const v2u zero2 = (v2u){0u, 0u};
    for (int u = bid; u < 256; u += G) {
        const int h = u & 15, dir = (u >> 4) & 1, b = (u >> 5) * 4 + q;
        __syncthreads();
        if (tid < 64) { CST[tid] = w0[dir * D + h * 64 + tid]; CST[64 + tid] = a0[dir * D + h * 64 + tid]; CST[128 + tid] = kkw[h * 64 + tid]; CST[192 + tid] = kaw[h * 64 + tid]; CST[256 + tid] = rkw[h * 64 + tid]; }
        for (int i = tid; i < 4096; i += NTHR) { const int c = i & 63, j = i >> 6; const size_t o = ((size_t)dir * 64 + j) * D + h * 64 + c;
            const int pj = ((((j >> 3) ^ (c & 7)) << 3) | (j & 7));
            ((LAS unsigned short*)(lds + O_W2))[c * 64 + pj] = (unsigned short)(pkbf(w2[o], 0.f) & 0xffffu); ((LAS unsigned short*)(lds + O_A2))[c * 64 + pj] = (unsigned short)(pkbf(a2[o], 0.f) & 0xffffu); }
        __syncthreads();
        if (role == 1) {
            struct PSet { v2u k[4], r[4]; v4u v0, v1; bf16x8 lw0, lw1, la0, la1; };
            PSet sA, sB;
#define WKV_ROW(ckx_, n16_) (((ckx_) < 16) ? (size_t)NLAT + b * CTXL + (dir == 0 ? (ckx_) * 16 + (n16_) : 255 - ((ckx_) * 16 + (n16_))) : (size_t)b * SEQ + (dir == 0 ? (ckx_) * 16 + (n16_) - 256 : 2047 - ((ckx_) * 16 + (n16_) - 256)))
#define WKV_LOAD(S_, ckx_, n16_, g_) do { const int cx_ = (ckx_); const size_t row_ = WKV_ROW(cx_, n16_); const bool ic_ = cx_ < 16; \
                const int blk_ = ic_ ? (dir == 0 ? cx_ : 15 - cx_) : (dir == 0 ? cx_ - 16 : 143 - cx_), tok_ = dir == 0 ? (n16_) : 15 - (n16_); \
                const size_t kb_ = ic_ ? (size_t)NLAT * 1024 + ((size_t)((b * 16 + h) * 16 + blk_)) * 1024 : ((size_t)((b * 16 + h) * 128 + blk_)) * 1024; \
                const size_t rb_ = ic_ ? 0 : kb_;        \
                const size_t lrow_ = ic_ ? (size_t)NLAT + b * CTXL + blk_ * 16 : (size_t)b * SEQ + blk_ * 16;        \
                _Pragma("unroll") for (int mt = 0; mt < 4; ++mt) { S_.k[mt] = *(const v2u*)(K + kb_ + mt * 256 + tok_ * 16 + 4 * (g_)); S_.r[mt] = *(const v2u*)(R + rb_ + mt * 256 + tok_ * 16 + 4 * (g_)); } \
                S_.v0 = *(const v4u*)(V + row_ * D + h * 64 + 8 * (g_)); S_.v1 = *(const v4u*)(V + row_ * D + h * 64 + 32 + 8 * (g_)); \
                { const bf16* lw_ = L + ((size_t)dir * NTOK + lrow_) * 64 + tok_ * 32 + 8 * (g_); const bf16* la_ = L + ((size_t)(2 + dir) * NTOK + lrow_) * 64 + tok_ * 32 + 8 * (g_); \
                  S_.lw0 = *(const bf16x8*)(lw_); S_.lw1 = *(const bf16x8*)(lw_ + 512); S_.la0 = *(const bf16x8*)(la_); S_.la1 = *(const bf16x8*)(la_ + 512); } } while (0)
            WKV_LOAD(sA, 0, lane & 15, lane >> 4); WKV_LOAD(sB, 1, lane & 15, lane >> 4);
            __builtin_amdgcn_s_setprio(2);
            float pend_bon = 0.f; long pend_idx = -1;
            auto prep_iter = [&](const int ck, PSet& S) __attribute__((always_inline)) {
                int ln_ = lane; asm volatile("" : "+v"(ln_));
                const int n16 = ln_ & 15, g = ln_ >> 4;
                const int ckn = ck + 1;
                if (pend_idx >= 0) { COEF[pend_idx] = pend_bon; pend_idx = -1; }
                if (ckn < 144 && variant != 1) {
                    LAS unsigned char* cb = lds + (q * 2 + (ckn & 1)) * CHB;
                    const bool iscn = ckn < 16;
                    const size_t row = WKV_ROW(ckn, n16);
                    v2u kraw[4], rraw[4];
#pragma unroll
                    for (int mt = 0; mt < 4; ++mt) { kraw[mt] = S.k[mt]; rraw[mt] = iscn ? zero2 : S.r[mt]; }
                    const v4u vr0 = S.v0, vr1 = S.v1; const bf16x8 lwf0 = S.lw0, lwf1 = S.lw1, laf0 = S.la0, laf1 = S.la1;
                    WKV_LOAD(S, (ckn + 2 < 144 ? ckn + 2 : 143), n16, g);
#ifdef PROBE_PREP2
                    for (int rr_ = 0; rr_ < 2; ++rr_)
#endif
                    {
                    if (variant != 3) { *(LAS v4u*)(cb + O_V + n16 * 144 + g * 16) = vr0; *(LAS v4u*)(cb + O_V + n16 * 144 + 64 + g * 16) = vr1; }
                    float Lc[16], ic[16], kkr[16]; float ss = 0.f;
#pragma unroll
                    for (int mt = 0; mt < 4; ++mt) {
                        const int sw0 = (g ^ (n16 & 7)) * 16, sw1 = ((4 + g) ^ (n16 & 7)) * 16;
                        const LAS unsigned char* wp = lds + O_W2 + (16 * mt + n16) * 128; const LAS unsigned char* ap = lds + O_A2 + (16 * mt + n16) * 128;
                        f32x4 wacc = zero4, aacc = zero4;
                        if (variant != 5) { wacc = MFMA16(*(const LAS bf16x8*)(wp + sw0), lwf0, zero4); wacc = MFMA16(*(const LAS bf16x8*)(wp + sw1), lwf1, wacc);
                        aacc = MFMA16(*(const LAS bf16x8*)(ap + sw0), laf0, zero4); aacc = MFMA16(*(const LAS bf16x8*)(ap + sw1), laf1, aacc); }
                        const f32x4 cw0 = *(const LAS f32x4*)(CST + 16 * mt + 4 * g), ca0 = *(const LAS f32x4*)(CST + 64 + 16 * mt + 4 * g), ckk = *(const LAS f32x4*)(CST + 128 + 16 * mt + 4 * g);
                        const float kf[4] = {bflo(kraw[mt].x), bfhi(kraw[mt].x), bflo(kraw[mt].y), bfhi(kraw[mt].y)};
#pragma unroll
                        for (int j = 0; j < 4; ++j) { const int e = mt * 4 + j;
                            Lc[e] = -0.8750387749145276f * sigmoid_fast(wacc[j] + cw0[j]);
                            ic[e] = sigmoid_fast(aacc[j] + ca0[j]); kkr[e] = kf[j] * ckk[j]; ss += kkr[e] * kkr[e]; }
                    }
                    ss = rows_sum(ss);
                    const float inv = rsqrtf(fmaxf(ss, 1e-24f));
#pragma unroll
                    for (int e = 0; e < 16; ++e) { float x = Lc[e]; x += dppz<0x111>(x); x += dppz<0x112>(x); x += dppz<0x114>(x); x += dppz<0x118>(x); Lc[e] = x; }
                    float bon = 0.f;
#pragma unroll
                    for (int x2 = 0; x2 < (variant == 4 ? 0 : 2); ++x2) {
                        float at8[8], rt8[8], bh8[8], kh8[8];
#pragma unroll
                        for (int mm = 0; mm < 2; ++mm) { const int mt = 2 * x2 + mm; const f32x4 cka = *(const LAS f32x4*)(CST + 192 + 16 * mt + 4 * g), crk = *(const LAS f32x4*)(CST + 256 + 16 * mt + 4 * g);
                            const float kf[4] = {bflo(kraw[mt].x), bfhi(kraw[mt].x), bflo(kraw[mt].y), bfhi(kraw[mt].y)}, rf[4] = {bflo(rraw[mt].x), bfhi(rraw[mt].x), bflo(rraw[mt].y), bfhi(rraw[mt].y)};
#pragma unroll
                            for (int j = 0; j < 4; ++j) { const int e = mt * 4 + j, o = mm * 4 + j;
                                float Wt = (variant == 6) ? Lc[e] : __builtin_amdgcn_exp2f(Lc[e]), iW = (variant == 6) ? -Lc[e] : __builtin_amdgcn_exp2f(-Lc[e]); const float Wm = (variant == 7) ? Wt : dpp_old<0x111>(1.f, Wt);
                                const float kk = kkr[e] * inv, kd = kf[j] * (1.f + (ic[e] - 1.f) * cka[j]), bb = kk * ic[e];
                                at8[o] = -kk * Wm; rt8[o] = rf[j] * Wt; bh8[o] = bb * iW; kh8[o] = kd * iW; bon += rf[j] * kd * crk[j];
                                } }
                        const int off = n16 * 144 + (x2 * 32 + g * 8) * 2;
                        if (variant != 8) { *(LAS v4u*)(cb + O_AT + off) = pack8(at8); *(LAS v4u*)(cb + O_RT + off) = pack8(rt8); *(LAS v4u*)(cb + O_BH + off) = pack8(bh8); *(LAS v4u*)(cb + O_KH + off) = pack8(kh8); }
                        else { *(LAS float*)(cb + O_AT + off) = at8[0] + at8[1] + at8[2] + at8[3] + at8[4] + at8[5] + at8[6] + at8[7] + rt8[0] + rt8[1] + rt8[2] + rt8[3] + rt8[4] + rt8[5] + rt8[6] + rt8[7] + bh8[0] + kh8[0]; }
                    }
                    if (n16 == 15) {
#pragma unroll
                        for (int mt = 0; mt < 4; ++mt) *(LAS f32x4*)(cb + O_WC + (16 * mt + 4 * g) * 4) = (f32x4){__builtin_amdgcn_exp2f(Lc[4 * mt]), __builtin_amdgcn_exp2f(Lc[4 * mt + 1]), __builtin_amdgcn_exp2f(Lc[4 * mt + 2]), __builtin_amdgcn_exp2f(Lc[4 * mt + 3])}; }
                    if (!iscn) { bon = rows_sum(bon); if (g == 0) { pend_bon = bon; pend_idx = (long)(((size_t)dir * NLAT + row) * 16 + h); } }
                    }
                }
                asm volatile("s_waitcnt lgkmcnt(0)" ::: "memory"); __builtin_amdgcn_s_barrier(); asm volatile("" ::: "memory");
            };
#pragma unroll 1
            for (int ck = -1; ck < 143; ck += 2) { prep_iter(ck, sA); prep_iter(ck + 1, sB); }
            prep_iter(143, sA);
            if (pend_idx >= 0) COEF[pend_idx] = pend_bon;
            __builtin_amdgcn_s_setprio(0);
#undef WKV_LOAD
#undef WKV_ROW
        } else {
            f32x4 st[4][4];
#pragma unroll
            for (int kt = 0; kt < 4; ++kt)
#pragma unroll
                for (int vt = 0; vt < 4; ++vt) st[kt][vt] = zero4;
            asm volatile("s_waitcnt lgkmcnt(0)" ::: "memory"); __builtin_amdgcn_s_barrier(); asm volatile("" ::: "memory");
#pragma unroll 1
            for (int ck = 0; ck < 144; ++ck) {
                int ln_ = lane; asm volatile("" : "+v"(ln_));
                const int n16 = ln_ & 15, g = ln_ >> 4;
                if (variant < 2) {
                const LAS unsigned char* cb = lds + (q * 2 + (ck & 1)) * CHB;
                bf16x8 bhf[2], khf[2], atf[2], rtf[2];
#pragma unroll
                for (int kp = 0; kp < 2; ++kp) { const int off = n16 * 144 + (kp * 32 + g * 8) * 2;
                    bhf[kp] = *(const LAS bf16x8*)(cb + O_BH + off); khf[kp] = *(const LAS bf16x8*)(cb + O_KH + off); atf[kp] = *(const LAS bf16x8*)(cb + O_AT + off); rtf[kp] = *(const LAS bf16x8*)(cb + O_RT + off); }
                f32x4 Nm = MFMA16(bhf[0], atf[0], zero4); Nm = MFMA16(bhf[1], atf[1], Nm);
                f32x4 Nt = MFMA16(atf[0], bhf[0], zero4); Nt = MFMA16(atf[1], bhf[1], Nt);
                f32x4 Aak = MFMA16(khf[0], atf[0], zero4); Aak = MFMA16(khf[1], atf[1], Aak);
                f32x4 Br = MFMA16(bhf[0], rtf[0], zero4); Br = MFMA16(bhf[1], rtf[1], Br);
                f32x4 Kr = MFMA16(khf[0], rtf[0], zero4); Kr = MFMA16(khf[1], rtf[1], Kr);
                f32x4 Pm, Pt;
#pragma unroll
                for (int j = 0; j < 4; ++j) { const int i = 4 * g + j; const bool lt = i < n16, le = i <= n16, gt_ = i > n16; const float dg = (i == n16) ? 1.f : 0.f;
                    Nm[j] = lt ? Nm[j] : 0.f; Nt[j] = gt_ ? Nt[j] : 0.f; Aak[j] = lt ? Aak[j] : 0.f; Br[j] = le ? Br[j] : 0.f; Kr[j] = le ? Kr[j] : 0.f; Pm[j] = Nm[j] + dg; Pt[j] = Nt[j] + dg; }
#define XY(xt_, y_, c_) MFMA16(mk8(pk4(xt_), zero2), mk8(pk4(y_), zero2), (c_))
                f32x4 M2 = XY(Nt, Nm, zero4), M2t = XY(Nm, Nt, zero4);
                { const f32x4 Pn = XY(Pt, M2, Pm), Ptn = XY(M2, Pt, Pt); Pm = Pn; Pt = Ptn; }
                const f32x4 M4 = XY(M2t, M2, zero4), M4t = XY(M2, M2t, zero4);
                { const f32x4 Pn = XY(Pt, M4, Pm), Ptn = XY(M4, Pt, Pt); Pm = Pn; Pt = Ptn; }
                const f32x4 M8 = XY(M4t, M4, zero4);
                const f32x4 tsel = XY(Pt, M8, Pm);
#undef XY
                const bf16x8 tfr = mk8(pk4(tsel), zero2), aakfr = mk8(pk4(Aak), zero2), bkfr = mk8(pk4(Br), pk4(Kr));
                const bool isc = ck < 16;
                bf16* yrow; { const int sl = ck * 16 + n16 - 256; const size_t row = (size_t)b * SEQ + (dir == 0 ? sl : 2047 - sl); yrow = Y + (size_t)dir * yds + (isc ? 0 : row) * D + h * 64 + 4 * g; }
#pragma unroll
                for (int vt = 0; vt < 4; ++vt) {
                    const LAS unsigned char* trb = cb + (4 * g + (n16 >> 2)) * 144 + (n16 & 3) * 8;
                    const v2u vm = __builtin_bit_cast(v2u, __builtin_amdgcn_ds_read_tr16_b64_v4i16((LAS short4v*)(trb + O_V + vt * 32)));
                    const bf16x8 sf0 = mk8(pk4(st[0][vt]), pk4(st[1][vt])), sf1 = mk8(pk4(st[2][vt]), pk4(st[3][vt]));
                    f32x4 gt = MFMA16(atf[0], sf0, zero4); gt = MFMA16(atf[1], sf1, gt); gt = MFMA16(aakfr, mk8(vm, zero2), gt);
                    const f32x4 ut = MFMA16(tfr, mk8(pk4(gt), zero2), zero4);
                    const bf16x8 uv = mk8(pk4(ut), vm);
                    if (!isc) {
                        f32x4 yv = MFMA16(sf0, rtf[0], zero4); yv = MFMA16(sf1, rtf[1], yv); yv = MFMA16(uv, bkfr, yv);
                        *(v2u*)(yrow + 16 * vt) = pk4(yv);
                    }
#pragma unroll
                    for (int kt = 0; kt < 4; ++kt) {
                        const v2u bt = __builtin_bit_cast(v2u, __builtin_amdgcn_ds_read_tr16_b64_v4i16((LAS short4v*)(trb + O_BH + (kt >> 1) * 64 + (kt & 1) * 8 + (n16 & 3) * 8))), kt2 = __builtin_bit_cast(v2u, __builtin_amdgcn_ds_read_tr16_b64_v4i16((LAS short4v*)(trb + O_KH + (kt >> 1) * 64 + (kt & 1) * 8 + (n16 & 3) * 8)));
                        st[kt][vt] = MFMA16(mk8(bt, kt2), uv, st[kt][vt]); }
                    asm volatile("" ::: "memory");
                }
#pragma unroll
                for (int kt = 0; kt < 4; ++kt) { const f32x4 wc = *(const LAS f32x4*)(cb + O_WC + (16 * kt + 4 * g) * 4);
#pragma unroll
                    for (int vt = 0; vt < 4; ++vt) st[kt][vt] *= wc; }
                }
                asm volatile("s_waitcnt lgkmcnt(0)" ::: "memory"); __builtin_amdgcn_s_barrier(); asm volatile("" ::: "memory");
            }
        }
    }
}
__device__ __forceinline__ void p_finish(const bf16* Y, size_t yds, const float* COEF, const bf16* V, const bf16* Gt, int gpitch, const float* gng, const float* gnb, bf16* A2, int gw, int NGW, int lane) {
    const int c0 = lane * 16, h = lane >> 2;
    float gw_[16], gb_[16];
#pragma unroll
    for (int i = 0; i < 16; ++i) { gw_[i] = gng[c0 + i]; gb_[i] = gnb[c0 + i]; }
    v4u n_y[4], n_v[2], n_g[2]; float n_b0 = 0.f, n_b1 = 0.f;
#define FIN_LOAD(r_) do { const size_t r = (size_t)(r_); n_y[0] = *(const v4u*)(Y + r * D + c0); n_y[1] = *(const v4u*)(Y + r * D + c0 + 8); n_y[2] = *(const v4u*)(Y + yds + r * D + c0); n_y[3] = *(const v4u*)(Y + yds + r * D + c0 + 8); \
        n_v[0] = *(const v4u*)(V + r * D + c0); n_v[1] = *(const v4u*)(V + r * D + c0 + 8); n_g[0] = *(const v4u*)(Gt + r * gpitch + c0); n_g[1] = *(const v4u*)(Gt + r * gpitch + c0 + 8); \
        n_b0 = COEF[r * 16 + h]; n_b1 = COEF[((size_t)NLAT + r) * 16 + h]; } while (0)
    if (gw < NLAT) FIN_LOAD(gw);
    for (int row = gw; row < NLAT; row += NGW) {
        float ys[16], t8[8]; v4u c_v[2], c_g[2];
        unpack8(n_y[0], t8);
#pragma unroll
        for (int i = 0; i < 8; ++i) ys[i] = t8[i];
        unpack8(n_y[1], t8);
#pragma unroll
        for (int i = 0; i < 8; ++i) ys[8 + i] = t8[i];
        unpack8(n_y[2], t8);
#pragma unroll
        for (int i = 0; i < 8; ++i) ys[i] += t8[i];
        unpack8(n_y[3], t8);
#pragma unroll
        for (int i = 0; i < 8; ++i) ys[8 + i] += t8[i];
        c_v[0] = n_v[0]; c_v[1] = n_v[1]; c_g[0] = n_g[0]; c_g[1] = n_g[1]; const float bon = n_b0 + n_b1;
        if (row + NGW < NLAT) FIN_LOAD(row + NGW);
        float s = 0.f;
#pragma unroll
        for (int i = 0; i < 16; ++i) s += ys[i];
        s = sum4(s); const float mu = s * (1.f / 64.f);
        float qv = 0.f;
#pragma unroll
        for (int i = 0; i < 16; ++i) { const float d = ys[i] - mu; qv += d * d; }
        qv = sum4(qv); const float rs = rsqrtf(qv * (1.f / 64.f) + 64e-5f);
#pragma unroll
        for (int hf = 0; hf < 2; ++hf) { float vf[8], gf[8], o[8]; unpack8(c_v[hf], vf); unpack8(c_g[hf], gf);
#pragma unroll
            for (int i = 0; i < 8; ++i) { const int c = c0 + 8 * hf + i; o[i] = ((ys[8 * hf + i] - mu) * rs * gw_[8 * hf + i] + gb_[8 * hf + i] + bon * vf[i]) * gf[i]; (void)c; }
            *(v4u*)(A2 + (size_t)row * D + c0 + 8 * hf) = pack8(o); }
    }
#undef FIN_LOAD
}
#ifndef PROBE_DUP
#define PROBE_DUP -1
#endif
#ifndef PROBE_N
#define PROBE_N 2
#endif
#define REP(k) ((PROBE_DUP == (k)) ? PROBE_N : 1)
#ifndef MK_PER_PHASE
#define MK_PER_PHASE 0
#endif
struct ConvJob { int in_idx, src_off, K, N, nmat, sms, dst_mib, dst_off, dms, pitch, koff, Kpad, mode, row_off, mu_idx, smode; };
#define LOR(idx, d, rowb, mi) {idx, (d) * 65536, 1024, 64, 1, 0, 28, 0, 0, 2048, 0, 1024, 0, (rowb) + (d) * 64, mi, 1}, {idx, (d) * 65536, 1024, 64, 1, 0, 28, 0, 0, 2048, 1024, 1024, 0, (rowb) + (d) * 64, mi, 2}
#define EXPERT(l) {9, (l) * 16777216, 1024, 1024, 16, 1048576, 46 + (l) * 96, 0, 2097152, 1024, 0, 1024, 1, 0, 0, 0}, {10, (l) * 16777216, 1024, 1024, 16, 1048576, 46 + (l) * 96, 0, 2097152, 1024, 0, 1024, 1, 4, 0, 0}, \
                  {11, (l) * 16777216, 1024, 1024, 16, 1048576, 46 + (l) * 96 + 64, 0, 1048576, 1024, 0, 1024, 0, 0, 0, 0}
__constant__ ConvJob CONV_JOBS[] = {
    {12, 0, 1024, QW, 1, 0, 22, 0, 0, 1024, 0, 1024, 0, 0, 0, 0},
    {13, 0, 1024, 1024, 1, 0, 26, 0, 0, 1024, 0, 1024, 0, 0, 0, 0},
    {37, 0, 1024, 1024, 1, 0, 43, 0, 0, 1024, 0, 1024, 0, 0, 0, 0},
    {31, 0, 160, 1024, 1, 0, 42, 0, 0, 256, 0, 256, 0, 0, 0, 0},
    {23, 0, 1024, 1024, 1, 0, 40, 0, 0, 1024, 0, 1024, 0, 0, 0, 0},
    {23, 1 * 1048576, 1024, 1024, 1, 0, 28, 0, 0, 1024, 0, 1024, 0, 0, 0, 0}, {23, 2 * 1048576, 1024, 1024, 1, 0, 30, 0, 0, 1024, 0, 1024, 0, 0, 0, 0},
    LOR(25, 0, 2048, 1), LOR(25, 1, 2048, 1), LOR(28, 0, 2176, 4), LOR(28, 1, 2176, 4),
    {30, 0, 1024, 160, 1, 0, 28, 0, 0, 2048, 0, 1024, 0, 2304, 5, 1}, {30, 0, 1024, 160, 1, 0, 28, 0, 0, 2048, 1024, 1024, 0, 2304, 5, 2},
    EXPERT(0), EXPERT(1)
};
constexpr int NJOBS = sizeof(CONV_JOBS) / sizeof(ConvJob);
constexpr int NPHASE = 24;
struct Args { const float* in[39]; float* out; unsigned char* ws; int ph_lo, ph_hi; };
__device__ __forceinline__ const float* ldp(const LAS unsigned long long* tab, int k) {
    const unsigned long long v = *(const volatile LAS unsigned long long*)(tab + k);
    const unsigned lo = __builtin_amdgcn_readfirstlane((unsigned)v), hi = __builtin_amdgcn_readfirstlane((unsigned)(v >> 32));
    return (const float*)(const GAS float*)(((unsigned long long)hi << 32) | lo);
}
__device__ __forceinline__ bool in_window(const LAS unsigned long long* tab, int k) {
    unsigned a = (unsigned)(size_t)(tab + 41); asm volatile("" : "+v"(a));
    const unsigned long long v = *(const volatile LAS unsigned long long*)a;
    const int lo = (int)__builtin_amdgcn_readfirstlane((unsigned)v), hi = (int)__builtin_amdgcn_readfirstlane((unsigned)(v >> 32));
    return lo <= k && k < hi;
}
__global__ void __launch_bounds__(NTHR, 2) mk_fwd(Args args) {
    extern __shared__ __attribute__((aligned(16))) unsigned char lds_raw[];
    LAS unsigned char* lds = (LAS unsigned char*)lds_raw;
    const int tid0 = threadIdx.x; const int wave_s = __builtin_amdgcn_readfirstlane(tid0 >> 6);
    const int G = gridDim.x, bid = blockIdx.x, NGW = G * NWAVES;
    volatile LAS unsigned* MISC = (volatile LAS unsigned*)(lds + MISC_OFF);
    LAS unsigned long long* tabw = (LAS unsigned long long*)(lds + TAB_OFF);
    const LAS unsigned long long* tab = tabw;
    for (int u = tid0; u < (LDS_BYTES - CTRL_BASE) / 4; u += NTHR) ((LAS unsigned*)(lds + CTRL_BASE))[u] = 0u;
    __syncthreads();
    if (tid0 == 0) {
#pragma unroll
        for (int i = 0; i < 39; ++i) tabw[i] = (unsigned long long)args.in[i];
        tabw[39] = (unsigned long long)args.ws; tabw[40] = (unsigned long long)args.out; tabw[41] = (unsigned long long)(unsigned)args.ph_lo | ((unsigned long long)(unsigned)args.ph_hi << 32);
    }
    __syncthreads();
    (void)xcd_barrier_post((unsigned*)(args.ws + WS_CTL) + CW_BAR, MISC + 8);
#define IN(k) in_window(tab, (k))
#define SEAM(k) do { if (IN(k) && IN((k) + 1)) { XcdBarrier b_; b_.bar = (unsigned*)ldp(tab, 39) + CW_BAR; b_.x = xb_xcc_id(); b_.st = MISC + 8; xcd_barrier(b_); } } while (0)
#define INP(k) ldp(tab, (k))
#define PH const int tid = opaque_tid(wave_s), lane = tid & 63, wave = __builtin_amdgcn_readfirstlane(tid >> 6), gw = bid * NWAVES + wave; (void)lane; (void)gw; \
           unsigned char* const ws = (unsigned char*)ldp(tab, 39); bf16* const xl = (bf16*)ldp(tab, 40); (void)ws; (void)xl
#define MODACC ((float*)(ws + WS_MOD))
#define ROPE ((float*)(ws + WS_ROPE))
#define AFFL ((float*)(ws + WS_AFFL))
#define AFFC ((float*)(ws + WS_AFFC))
#define STOK ((int*)(ws + (layer == 0 ? WS_STOK : WS_STOK1)))
#define SGATE ((float*)(ws + WS_SGATE))
#define INVT ((short*)(ws + WS_INV))
#define COEF ((float*)(ws + WS_COEF))
#define WIN_T ((bf16*)(ws + WS_WIN))
#define WOUT_T ((bf16*)(ws + WS_WOUT))
#define WBIG_T ((bf16*)(ws + WS_WBIG))
#define WR_T ((bf16*)(ws + WS_WR))
#define G2_T ((bf16*)(ws + WS_G2))
#define WO_T ((bf16*)(ws + WS_WO))
#define XCP ((bf16*)(ws + WS_XC))
#define HB ((bf16*)(ws + WS_H))
#define R1P ((bf16*)(ws + WS_R1))
#define R2P ((bf16*)(ws + WS_R2))
#define LORAP ((bf16*)(ws + WS_LORA))
#define A2P (R1P + (size_t)NTOK * D)

    if (IN(0)) { PH;
        for (int rep = 0; rep < REP(40); ++rep) p_mods(INP(1), INP(3), INP(4), INP(5), MODACC, lds, bid, G, tid);
        { float* rope = ROPE; for (int i = bid * NTHR + tid; i < 96 * 16; i += G * NTHR) { const int pos = i >> 4, f = i & 15, pp = pos < 32 ? pos : pos - 32; const float ivf = powf(10000.f, -(float)(2 * f) / 32.f), ang = (float)pp * ivf; rope[2 * i] = cosf(ang); rope[2 * i + 1] = sinf(ang); } }
        __syncthreads();
        LAS float* scr = (LAS float*)(lds + wave * 16640);
#ifdef PROBE_CONV_VARIANT
        { int gstart = 0;
        for (int jx = 0; jx < NJOBS; ++jx) {
            const ConvJob J = CONV_JOBS[jx]; int gcount = 0;
            conv_items(INP(J.in_idx) + J.src_off, J.K, J.N, J.nmat, (size_t)J.sms, (bf16*)(ws + (size_t)J.dst_mib * MiB) + J.dst_off, (size_t)J.dms, J.pitch, J.koff, J.Kpad, J.mode, J.row_off, INP(22) + J.mu_idx * 1024, J.smode, scr, gw, NGW, lane, gstart, gcount, PROBE_CONV_VARIANT);
            gstart += gcount;
        } }
#endif
        for (int rep = 0; rep < REP(0); ++rep) {
        { int gstart = 0;
          for (int jx = 0; jx < NJOBS; ++jx) { const ConvJob J = CONV_JOBS[jx]; if ((J.K & 255) || (J.N & 255)) continue; int gcount = 0;
              conv_block_items(INP(J.in_idx) + J.src_off, J.K, J.N, J.nmat, (size_t)J.sms, (bf16*)(ws + (size_t)J.dst_mib * MiB) + J.dst_off, (size_t)J.dms, J.pitch, J.koff, J.mode, J.row_off, INP(22) + J.mu_idx * 1024, J.smode, lds, bid, G, tid, gstart, gcount);
              gstart += gcount; } }
        { int gstart = 0;
          for (int jx = 0; jx < NJOBS; ++jx) { const ConvJob J = CONV_JOBS[jx]; if (!((J.K & 255) || (J.N & 255))) continue; int gcount = 0;
              conv_items(INP(J.in_idx) + J.src_off, J.K, J.N, J.nmat, (size_t)J.sms, (bf16*)(ws + (size_t)J.dst_mib * MiB) + J.dst_off, (size_t)J.dms, J.pitch, J.koff, J.Kpad, J.mode, J.row_off, INP(22) + J.mu_idx * 1024, J.smode, scr, gw, NGW, lane, gstart, gcount);
              gstart += gcount; } } }
        { v4u* z = (v4u*)(WBIG_T + (size_t)2464 * 2048); const int n16 = 96 * 2048 * 2 / 16; for (int i = bid * NTHR + tid; i < n16; i += G * NTHR) z[i] = (v4u){0u, 0u, 0u, 0u}; }
    }
    SEAM(0);
    for (int layer = 0; layer < 2; ++layer) {
        if (layer == 0) {
            if (IN(1)) { PH; for (int rep = 0; rep < REP(1); ++rep) p_norm0(INP(0), INP(2), INP(6), MODACC, HB, gw, NGW, lane); }
            SEAM(1);
#ifdef PROBE_BARRIERS
            if (IN(1)) for (int rb_ = 0; rb_ < PROBE_BARRIERS; ++rb_) { XcdBarrier b_; b_.bar = (unsigned*)ldp(tab, 39) + CW_BAR; b_.x = xb_xcc_id(); b_.st = MISC + 8; xcd_barrier(b_); }
#endif
            if (IN(2)) { PH; pg8::Gemm g{HB, WIN_T, NTOK, QW, 1024, 1024, 1 << 30, 0, nullptr}; pg8::StaticOrder S; S.init(NTOK, QW, G, bid); pg8::EpiBf16 E{R1P, QW};
                for (int rep = 0; rep < REP(2); ++rep) pg8::gemm_phase<pg8::EpiBf16, pg8::StaticOrder, true, true>(lds, g, S, E, wave_s); }
            SEAM(2);
            if (IN(3)) { PH; for (int rep = 0; rep < REP(30); ++rep) { p_attn(R1P, ROPE, INP(14), HB, lds, bid, G, tid); __syncthreads(); }
                #ifdef PROBE_LRU_VARIANT
                p_lru(R1P, INP(15), INP(16), INP(17), INP(18), INP(19), INP(20), INP(21), (float*)R2P, HB, lds, bid, G, tid, PROBE_LRU_VARIANT); __syncthreads();
#endif
                for (int rep = 0; rep < REP(31); ++rep) { p_lru(R1P, INP(15), INP(16), INP(17), INP(18), INP(19), INP(20), INP(21), (float*)R2P, HB, lds, bid, G, tid); __syncthreads(); } }
            SEAM(3);
        } else {
            if (IN(11)) { PH; for (int rep = 0; rep < REP(11); ++rep) p_shift(R2P, INP(22), xl + 1024, 2048, HB, R1P, gw, NGW, lane); }
            do { if (IN(11) && IN(23)) { XcdBarrier b_; b_.bar = (unsigned*)ldp(tab, 39) + CW_BAR; b_.x = xb_xcc_id(); b_.st = MISC + 8; xcd_barrier(b_); } } while (0);
            if (IN(23)) { PH;
                { pg8::Gemm g{R2P, WBIG_T + (size_t)2048 * 2048, NTOK, 512, 2048, 2048, 1 << 30, 0, nullptr}; pg8::StaticOrder S; S.init(NTOK, 512, G, bid); pg8::EpiRwkv E{HB, R1P, LORAP, NLAT, 8, NTOK};
                  pg8::gemm_phase<pg8::EpiRwkv, pg8::StaticOrder, true, true>(lds, g, S, E, wave_s); }
                { pg8::Gemm g{xl + 1024, WR_T, NLAT, 1024, 1024, 2048, 1 << 30, 0, nullptr}; pg8::StaticOrder S; S.init(NLAT, 1024, G, bid); if (G == 256) S.skip = 64;
                  pg8::EpiHm E{A2P, NLAT};
                  pg8::gemm_phase<pg8::EpiHm, pg8::StaticOrder, true, true>(lds, g, S, E, wave_s); } }
            do { if (IN(23) && IN(12)) { XcdBarrier b_; b_.bar = (unsigned*)ldp(tab, 39) + CW_BAR; b_.x = xb_xcc_id(); b_.st = MISC + 8; xcd_barrier(b_); } } while (0);
            if (IN(12)) { PH;
                for (int rep = 0; rep < REP(12); ++rep) {
                { pg8::Gemm g{HB, WBIG_T, NTOK, 1024, 1024, 1024, 1 << 30, 0, nullptr}; pg8::StaticOrder S; S.init(NTOK, 1024, G, bid); pg8::EpiHm E{R2P, NLAT};
                  pg8::gemm_phase<pg8::EpiHm, pg8::StaticOrder, true, true>(lds, g, S, E, wave_s); }
                { pg8::Gemm g{R1P, WBIG_T + (size_t)1024 * 1024, NTOK, 1024, 1024, 1024, 1 << 30, 0, nullptr}; pg8::StaticOrder S; S.init(NTOK, 1024, G, G - 1 - bid); pg8::EpiBf16 E{R2P + (size_t)NTOK * D, 1024};
                  pg8::gemm_phase<pg8::EpiBf16, pg8::StaticOrder, true, true>(lds, g, S, E, wave_s); }
                { pg8::Gemm g{LORAP, G2_T, NLAT, 1024, 256, 256, 1 << 30, 0, nullptr}; pg8::StaticOrder S; S.init(NLAT, 1024, G, bid); pg8::EpiBf16 E{xl + 1024, 2048};
                  pg8::gemm_phase<pg8::EpiBf16, pg8::StaticOrder, true, true>(lds, g, S, E, wave_s); } } }
            SEAM(12);
            if (IN(13)) { PH;
#ifdef PROBE_WKV_VARIANT
                p_wkv(A2P, R2P, R2P + (size_t)NTOK * D, LORAP + (size_t)NTOK * 256, INP(24), INP(26), INP(27), INP(29), INP(32), INP(33), INP(34), HB, (size_t)NTOK * D, COEF, lds, bid, G, tid, PROBE_WKV_VARIANT);
#endif
                for (int rep = 0; rep < REP(13); ++rep) p_wkv(A2P, R2P, R2P + (size_t)NTOK * D, LORAP + (size_t)NTOK * 256, INP(24), INP(26), INP(27), INP(29), INP(32), INP(33), INP(34), HB, (size_t)NTOK * D, COEF, lds, bid, G, tid); }
            SEAM(13);
            if (IN(15)) { PH; for (int rep = 0; rep < REP(15); ++rep) p_finish(HB, (size_t)NTOK * D, COEF, R2P + (size_t)NTOK * D, xl + 1024, 2048, INP(35), INP(36), A2P, gw, NGW, lane); }
            SEAM(15);
        }
        { const int ph = layer == 0 ? 4 : 16;
          if (IN(ph)) { PH; const int M = layer == 0 ? NTOK : NLAT; const bf16* A = layer == 0 ? HB : A2P; const bf16* Bt = layer == 0 ? WOUT_T : WO_T;
              pg8::Gemm g{A, Bt, M, 1024, 1024, 1024, 1 << 30, 0, nullptr}; pg8::StaticOrder S; S.init(M, 1024, G, bid);
              pg8::EpiRes E{layer == 0 ? (const void*)INP(0) : (const void*)xl, xl, (const void*)INP(2), XCP, MODACC + (size_t)layer * 33 * MODW + 2 * 1024, NLAT, SEQ, MODW, 2048, 1024, layer};
              for (int rep = 0; rep < ((layer == 0) ? REP(4) : 1); ++rep) pg8::gemm_phase<pg8::EpiRes, pg8::StaticOrder, true, true>(lds, g, S, E, wave_s); }
          SEAM(ph); }
        { const int pb = layer == 0 ? 5 : 17; const int nrows = layer == 0 ? NTOK : NLAT; const int rpe = layer == 0 ? 9216 : 8192;
          if (IN(pb)) { PH; for (int rep = 0; rep < REP(5); ++rep) p_norm_router(xl, XCP, nrows, INP(7) + layer * 1024, MODACC + (size_t)layer * 33 * MODW, INP(8) + (size_t)layer * 16384, HB, AFFL, AFFC, lds, bid, G, tid); }
          SEAM(pb);
          if (IN(pb + 1)) { PH; for (int rep = 0; rep < REP(6); ++rep) p_topk(AFFL, AFFC, layer == 0 ? 1024 : 512, rpe, STOK, SGATE, INVT, gw, NGW, lane); }
          do { if (IN(pb + 1) && IN(pb + 3)) { XcdBarrier b_; b_.bar = (unsigned*)ldp(tab, 39) + CW_BAR; b_.x = xb_xcc_id(); b_.st = MISC + 8; xcd_barrier(b_); } } while (0);
#ifdef PROBE_FP8
          if (IN(pb + 3) && layer == 0) { PH; bf16* up_t = (bf16*)(ws + WS_EW + (size_t)layer * 96 * MiB);
              pg8::Gemm g{R1P, up_t, 16 * rpe, 2048, 512, 1024, rpe / 256, (size_t)2048 * 1024 * 2, nullptr}; pg8::StaticOrder S; S.init(16 * rpe, 2048, G, bid); pg8::EpiSwiglu E{R2P, 1024};
              pg8::gemm_phase<pg8::EpiSwiglu, pg8::StaticOrder, true, true, true>(lds, g, S, E, wave_s); }
#endif
          if (IN(pb + 3)) { PH; bf16* up_t = (bf16*)(ws + WS_EW + (size_t)layer * 96 * MiB);
              pg8::Gemm g{HB, up_t, 16 * rpe, 2048, 1024, 1024, rpe / 256, (size_t)2048 * 1024 * 2, STOK}; pg8::StaticOrder S; S.init(16 * rpe, 2048, G, bid); pg8::EpiSwiglu E{R2P, 1024};
              for (int rep = 0; rep < REP(8); ++rep) pg8::gemm_phase<pg8::EpiSwiglu, pg8::StaticOrder, true, true, false, true>(lds, g, S, E, wave_s); }
          SEAM(pb + 3);
          if (IN(pb + 4)) { PH; bf16* down_t = (bf16*)(ws + WS_EW + (size_t)layer * 96 * MiB) + (size_t)16 * 2048 * 1024;
              pg8::Gemm g{R2P, down_t, 16 * rpe, 1024, 1024, 1024, rpe / 256, (size_t)1024 * 1024 * 2, nullptr}; pg8::StaticOrder S; S.init(16 * rpe, 1024, G, bid); pg8::EpiBf16 E{R1P, 1024};
              for (int rep = 0; rep < REP(9); ++rep) pg8::gemm_phase<pg8::EpiBf16, pg8::StaticOrder, true, true>(lds, g, S, E, wave_s); }
          SEAM(pb + 4);
          if (IN(pb + 5)) { PH; const float* modl = MODACC + (size_t)layer * 33 * MODW;
              if (layer == 0) p_combine<0>(xl, XCP, NTOK, R1P, SGATE, INVT, rpe, modl, MODACC + (size_t)33 * MODW, INP(6) + 1024, R2P, gw, NGW, lane);
              else p_combine<1>(xl, XCP, NLAT, R1P, SGATE, INVT, rpe, modl, modl, INP(38), R2P, gw, NGW, lane); }
          if (layer == 0) SEAM(pb + 5); }
    }
#undef IN
#undef SEAM
}

extern "C" void kernel_launch(void* const* d_in, const int* in_sizes, int n_in, void* d_out, int out_size, void* d_ws, size_t ws_size, hipStream_t stream) {
    static int grid = 0;
    if (grid == 0) {
        if (n_in != 39 || out_size != NLAT * D || ws_size < WS_END) { fprintf(stderr, "kernel_launch: unexpected problem (n_in %d out %d ws %zu)\n", n_in, out_size, ws_size); grid = -1; return; }
        int dev = 0, cus = 0, per_cu = 0;
        if (hipGetDevice(&dev) != hipSuccess || hipDeviceGetAttribute(&cus, hipDeviceAttributeMultiprocessorCount, dev) != hipSuccess) { grid = -1; return; }
        if (hipFuncSetAttribute((const void*)mk_fwd, hipFuncAttributeMaxDynamicSharedMemorySize, LDS_BYTES) != hipSuccess) { fprintf(stderr, "kernel_launch: hipFuncSetAttribute failed\n"); grid = -1; return; }
        if (hipOccupancyMaxActiveBlocksPerMultiprocessor(&per_cu, (const void*)mk_fwd, NTHR, LDS_BYTES) != hipSuccess || per_cu < 1) fprintf(stderr, "kernel_launch: occupancy query says %d\n", per_cu);
        (void)hipGetLastError();
        grid = cus;
    }
    if (grid < 0) return;
    (void)hipMemsetAsync((char*)d_ws + WS_CTL, 0, CTL_ZERO_BYTES, stream);
    Args a{};
    for (int i = 0; i < 39; ++i) a.in[i] = (const float*)d_in[i];
    a.out = (float*)d_out; a.ws = (unsigned char*)d_ws;
#if MK_PER_PHASE
    for (int i = 0; i < NPHASE; ++i) { const int k = (i <= 11) ? i : (i == 12 ? 23 : i - 1);
        a.ph_lo = k; a.ph_hi = k + 1; hipLaunchKernelGGL(mk_fwd, dim3(grid), dim3(NTHR), LDS_BYTES, stream, a); }
#else
    a.ph_lo = 0; a.ph_hi = NPHASE; hipLaunchKernelGGL(mk_fwd, dim3(grid), dim3(NTHR), LDS_BYTES, stream, a);
#endif
}
```
